# Optimizing an MI355X kernel written in HIP

```python
import jax, jax.numpy as jnp
from jax import lax
import numpy as np

D_MODEL = 2048
BATCH = 4
SEQ = 4096
DEPTH = 2

CONV_GROUPS = 8
CONV_WIDTH = D_MODEL // 2
CONV_K = 3
SGU_GROUPS = 8
SGU_WIDTH = D_MODEL // 2
SGU_GROUP_DIM = SGU_WIDTH // SGU_GROUPS
CHUNK = 128
N_BRANCH = 2
BRANCH_WIDTH = CONV_WIDTH
D_IN = 3 * CONV_WIDTH + 2 * SGU_WIDTH + N_BRANCH * D_MODEL
N_EXPERT_GROUPS = 4
EXPERTS_PER_GROUP = 8
N_EXPERTS = N_EXPERT_GROUPS * EXPERTS_PER_GROUP
TOP_K = 2
D_EXPERT = D_MODEL // 4
MOE_BLOCK = 128
EPS = 1e-6

kernel_name = "hybrid_conv_sgu_hmoe_block"


def rmsnorm(x, g):
    xf = x.astype(jnp.float32)
    y = xf * lax.rsqrt(jnp.mean(xf * xf, axis=-1, keepdims=True) + EPS)
    return (y * g.astype(jnp.float32)).astype(x.dtype)


def layernorm(x, g, b):
    xf = x.astype(jnp.float32)
    mu = jnp.mean(xf, axis=-1, keepdims=True)
    xc = xf - mu
    var = jnp.mean(xc * xc, axis=-1, keepdims=True)
    y = xc * lax.rsqrt(var + EPS)
    return (y * g.astype(jnp.float32) + b.astype(jnp.float32)).astype(x.dtype)


def hybrid_mixer(xn, w_in, b_gate, conv_w, ln_v_g, ln_v_b, sgu_w, sgu_b, w_branch, w_out):
    bsz, s, _ = xn.shape
    proj = xn @ w_in
    c_pre, b_post, xa, z, gates = jnp.split(
        proj, [CONV_WIDTH, 2 * CONV_WIDTH, 3 * CONV_WIDTH, 3 * CONV_WIDTH + 2 * SGU_WIDTH], axis=-1)

    xc = c_pre * xa
    xp = jnp.pad(xc, ((0, 0), (CONV_K - 1, 0), (0, 0)))
    conv = conv_w[0] * xp[:, 0:s]
    for k in range(1, CONV_K):
        conv = conv + conv_w[k] * xp[:, k:k + s]
    y_a = b_post * conv

    z = jax.nn.gelu(z)
    u, v = jnp.split(z, 2, axis=-1)
    v = layernorm(v, ln_v_g, ln_v_b)
    v = v.reshape(bsz, s // CHUNK, CHUNK, SGU_GROUPS, SGU_GROUP_DIM)
    causal = jnp.tril(jnp.ones((CHUNK, CHUNK), dtype=bool))
    ws = jnp.where(causal[None], sgu_w, jnp.zeros_like(sgu_w))
    mixed = jnp.einsum('gts,bnsgc->bntgc', ws, v) + sgu_b.T[:, :, None]
    y_b = u * mixed.reshape(bsz, s, SGU_WIDTH)

    branches = jnp.stack([y_a, y_b], axis=2)
    br = jnp.einsum('bsrw,rwd->bsrd', branches, w_branch)
    g = jax.nn.sigmoid(gates + b_gate).reshape(bsz, s, N_BRANCH, D_MODEL)
    merged = jnp.sum(g * br, axis=2)
    return merged @ w_out


def hier_moe(xn, router_g, router_g_b, router_e, router_e_b, w_gate, w_up, w_down):
    bsz, s, d = xn.shape
    n = bsz * s
    xt = xn.reshape(n, d)
    g_logits = (xt @ router_g + router_g_b).astype(jnp.float32)
    g_prob = jax.nn.softmax(g_logits, axis=-1)
    g_idx = jnp.argmax(g_logits, axis=-1)
    g_w = jnp.take_along_axis(g_prob, g_idx[:, None], axis=1)[:, 0]
    e_logits = (xt @ router_e + router_e_b).astype(jnp.float32).reshape(n, N_EXPERT_GROUPS, EXPERTS_PER_GROUP)
    e_sel = jnp.take_along_axis(e_logits, g_idx[:, None, None], axis=1)[:, 0]
    e_prob = jax.nn.softmax(e_sel, axis=-1)
    top_w, top_i = lax.top_k(e_prob, TOP_K)
    top_w = top_w / jnp.sum(top_w, axis=-1, keepdims=True)
    expert_id = (g_idx[:, None] * EXPERTS_PER_GROUP + top_i).astype(jnp.int32)
    weight = (g_w[:, None] * top_w).astype(xt.dtype)

    a = n * TOP_K
    flat_e = expert_id.reshape(a)
    flat_tok = jnp.repeat(jnp.arange(n, dtype=jnp.int32), TOP_K)
    flat_w = weight.reshape(a)
    order = jnp.argsort(flat_e)
    sorted_e = flat_e[order]
    counts = jnp.bincount(flat_e, length=N_EXPERTS).astype(jnp.int32)
    start = jnp.cumsum(counts) - counts
    padded = (counts + MOE_BLOCK - 1) // MOE_BLOCK * MOE_BLOCK
    pad_end = jnp.cumsum(padded)
    pad_start = pad_end - padded
    rank = jnp.arange(a, dtype=jnp.int32) - start[sorted_e]
    dest = pad_start[sorted_e] + rank
    p = -(-a // MOE_BLOCK) * MOE_BLOCK + N_EXPERTS * MOE_BLOCK
    buf_tok = jnp.zeros((p,), jnp.int32).at[dest].set(flat_tok[order])
    buf_w = jnp.zeros((p,), xt.dtype).at[dest].set(flat_w[order])
    n_blocks = p // MOE_BLOCK
    block_e = jnp.minimum(
        jnp.searchsorted(pad_end, jnp.arange(n_blocks, dtype=jnp.int32) * MOE_BLOCK, side='right'),
        N_EXPERTS - 1)
    xb = xt[buf_tok].reshape(n_blocks, MOE_BLOCK, d)

    def expert_block(args):
        xblk, e = args
        h = jax.nn.silu(xblk @ w_gate[e]) * (xblk @ w_up[e])
        return h @ w_down[e]

    yb = lax.map(expert_block, (xb, block_e))
    y = jax.ops.segment_sum(yb.reshape(p, d) * buf_w[:, None], buf_tok, num_segments=n)
    return y.reshape(bsz, s, d)


def setup_inputs(seed: int = 0) -> dict:
    key = jax.random.key(seed)
    ks = jax.random.split(key, 24)

    def nrm(k, shape, scale):
        return jax.random.normal(k, shape, jnp.float32) * scale

    d = D_MODEL
    return {
        "x": nrm(ks[0], (BATCH, SEQ, d), 1.0),
        "norm1_g": 1.0 + nrm(ks[1], (DEPTH, d), 0.02),
        "w_in": nrm(ks[2], (DEPTH, d, D_IN), d ** -0.5),
        "b_gate": nrm(ks[3], (DEPTH, N_BRANCH * d), 0.02),
        "conv_w": nrm(ks[4], (DEPTH, CONV_K, CONV_WIDTH), CONV_K ** -0.5),
        "ln_v_g": 1.0 + nrm(ks[5], (DEPTH, SGU_WIDTH), 0.02),
        "ln_v_b": nrm(ks[6], (DEPTH, SGU_WIDTH), 0.02),
        "sgu_w": nrm(ks[7], (DEPTH, SGU_GROUPS, CHUNK, CHUNK), CHUNK ** -0.5),
        "sgu_b": 1.0 + nrm(ks[8], (DEPTH, SGU_GROUPS, CHUNK), 0.02),
        "w_branch": nrm(ks[9], (DEPTH, N_BRANCH, BRANCH_WIDTH, d), BRANCH_WIDTH ** -0.5),
        "w_out": nrm(ks[10], (DEPTH, d, d), d ** -0.5),
        "norm2_g": 1.0 + nrm(ks[11], (DEPTH, d), 0.02),
        "router_g": nrm(ks[12], (DEPTH, d, N_EXPERT_GROUPS), d ** -0.5),
        "router_g_b": nrm(ks[13], (DEPTH, N_EXPERT_GROUPS), 0.01),
        "router_e": nrm(ks[14], (DEPTH, d, N_EXPERTS), d ** -0.5),
        "router_e_b": nrm(ks[15], (DEPTH, N_EXPERTS), 0.01),
        "w_gate": nrm(ks[16], (DEPTH, N_EXPERTS, d, D_EXPERT), d ** -0.5),
        "w_up": nrm(ks[17], (DEPTH, N_EXPERTS, d, D_EXPERT), d ** -0.5),
        "w_down": nrm(ks[18], (DEPTH, N_EXPERTS, D_EXPERT, d), D_EXPERT ** -0.5),
        "final_g": 1.0 + nrm(ks[19], (d,), 0.02),
    }


def reference(x, norm1_g, w_in, b_gate, conv_w, ln_v_g, ln_v_b, sgu_w, sgu_b, w_branch, w_out,
              norm2_g, router_g, router_g_b, router_e, router_e_b, w_gate, w_up, w_down, final_g):
    h = x
    for l in range(DEPTH):
        h = h + hybrid_mixer(rmsnorm(h, norm1_g[l]), w_in[l], b_gate[l], conv_w[l], ln_v_g[l], ln_v_b[l],
                             sgu_w[l], sgu_b[l], w_branch[l], w_out[l])
        h = h + hier_moe(rmsnorm(h, norm2_g[l]), router_g[l], router_g_b[l], router_e[l], router_e_b[l],
                         w_gate[l], w_up[l], w_down[l])
    return rmsnorm(h, final_g)
```

```cpp
#include <hip/hip_runtime.h>
#include <cstdio>
#include <cstdint>

#ifndef GEMM_MODE
#define GEMM_MODE 2
#endif
#ifndef GM_G1
#define GM_G1 GEMM_MODE
#endif
#ifndef GM_G2
#define GM_G2 GEMM_MODE
#endif
#ifndef GM_G3
#define GM_G3 GEMM_MODE
#endif
#ifndef GM_G4
#define GM_G4 GEMM_MODE
#endif
#ifndef GM_G5
#define GM_G5 GEMM_MODE
#endif

#ifndef KREP_G1
#define KREP_G1 1
#endif
#ifndef KREP_G3
#define KREP_G3 1
#endif
#ifndef KREP_G5
#define KREP_G5 1
#endif
#ifndef NT_STORE
#define YS_F8_FROM 1
#define G1_F8_FROM 1
#define G1_SPLIT 3072
#define G2_F8_FROM 1
#define G3_F8_FROM 1
#define NT_STORE 0
#endif
#ifndef P0_PROBE
#define P0_PROBE 0
#endif
#ifndef ROUTER_SPLIT
#define ROUTER_SPLIT 0
#endif
#ifndef REP_R1
#define REP_R1 1
#endif
#ifndef REP_R2
#define REP_R2 1
#endif
#ifndef REP_P0
#define REP_P0 1
#endif
#ifndef REP_G1
#define REP_G1 1
#endif
#ifndef REP_MID
#define REP_MID 1
#endif
#ifndef REP_G2
#define REP_G2 1
#endif
#ifndef REP_G3L0
#define REP_G3L0 1
#endif
#ifndef REP_G4
#define REP_G4 1
#endif
#ifndef REP_G5
#define REP_G5 1
#endif
#define LAS __attribute__((address_space(3)))
#define GAS __attribute__((address_space(1)))
typedef unsigned short bf16;
typedef short bf16x8 __attribute__((ext_vector_type(8)));
typedef float f32x4 __attribute__((ext_vector_type(4)));
typedef float f32x2 __attribute__((ext_vector_type(2)));
typedef unsigned u32x4 __attribute__((ext_vector_type(4)));
typedef unsigned u32x2 __attribute__((ext_vector_type(2)));

constexpr int NTOK = 16384, D = 2048, DEPTH = 2, SEQ = 4096;
constexpr int CW = 1024;
constexpr int DIN = 9216;
constexpr int NE = 32, DE = 512, EPG = 8, NGRP = 4;
constexpr int CHUNK = 128, SG = 8;
constexpr int PROWS = 40960;
constexpr int LISTCAP = 16384;
constexpr float EPS = 1e-6f;
constexpr int NWAVES = 8;

constexpr size_t MiB = 1u << 20;
constexpr size_t WS_CTL = 0, CTL_ZERO_BYTES = 64 * 1024;
constexpr size_t WS_TOKINFO = 1 * MiB;
constexpr size_t WS_RT = 2 * MiB;
constexpr size_t WS_TOKLIST = 3 * MiB;
constexpr size_t WS_VSTAT = 1008 * MiB;
constexpr size_t WS_WIN = 8 * MiB;
constexpr size_t WS_WBR = 80 * MiB;
constexpr size_t WS_WOUT = 96 * MiB;
constexpr size_t WS_WGU = 112 * MiB;
constexpr size_t WS_WIN8 = 240 * MiB;
constexpr size_t WS_XN8 = 944 * MiB;
constexpr size_t WS_WD = 368 * MiB;
constexpr size_t WS_H1 = 560 * MiB;
constexpr size_t WS_H = 496 * MiB;
constexpr size_t WS_XN = 624 * MiB;
constexpr size_t WS_XC = 688 * MiB, WS_BB = 720 * MiB, WS_U = 752 * MiB, WS_V = 784 * MiB, WS_GR = 816 * MiB, WS_GB = 880 * MiB;
constexpr size_t WS_YSLOT = 688 * MiB;
constexpr size_t WS_YAB = 944 * MiB;
constexpr size_t WS_HMID = 944 * MiB;
constexpr size_t WS_DELTA = 880 * MiB;
constexpr size_t WS_END = 1010 * MiB;
constexpr int CW_TMO = 0;
constexpr int CW_BAR = 4096;
constexpr int CW_CNT = 8192;

constexpr int RING_BYTES = 131072;
constexpr int P0_SCR = 64 * 65 * 4;
constexpr int MISC_OFF = 8 * P0_SCR + 2048;
constexpr int LDS_BYTES = 147456;

#define LDS_WAIT() asm volatile("s_waitcnt lgkmcnt(0)" ::: "memory")
#define VM_WAIT() asm volatile("s_waitcnt vmcnt(0)" ::: "memory")

__device__ __forceinline__ unsigned cvt_pk_bf16(float lo, float hi) { unsigned r; asm volatile("v_cvt_pk_bf16_f32 %0, %1, %2" : "=v"(r) : "v"(lo), "v"(hi)); return r; }
__device__ __forceinline__ unsigned pk4_fp8(float a, float b, float c, float d) { int w = 0; w = __builtin_amdgcn_cvt_pk_fp8_f32(a, b, w, false); w = __builtin_amdgcn_cvt_pk_fp8_f32(c, d, w, true); return (unsigned)w; }
__device__ __forceinline__ float bflo(unsigned w) { return __uint_as_float(w << 16); }
__device__ __forceinline__ float bfhi(unsigned w) { return __uint_as_float(w & 0xffff0000u); }
__device__ __forceinline__ float fast_sigmoid(float x) { return __builtin_amdgcn_rcpf(1.0f + __builtin_amdgcn_exp2f(-1.44269504f * x)); }
__device__ __forceinline__ float gelu_tanh(float x) { const float y = 0.7978845608f * (x + 0.044715f * x * x * x); return x * fast_sigmoid(2.0f * y); }
__device__ __forceinline__ f32x4 gelu_tanh4(const f32x4 x) {
    const float C1 = -2.0f * 0.7978845608f * 1.44269504f, C3 = C1 * 0.044715f;
    const f32x4 z = x * ((x * x) * C3 + C1); f32x4 t;
#pragma unroll
    for (int j = 0; j < 4; ++j) t[j] = __builtin_amdgcn_exp2f(z[j]);
    t = t + 1.0f;
#pragma unroll
    for (int j = 0; j < 4; ++j) t[j] = __builtin_amdgcn_rcpf(t[j]);
    return x * t;
}
__device__ __forceinline__ float wave_sum(float v) {
    int x = __float_as_int(v);
    v += __int_as_float(__builtin_amdgcn_update_dpp(0, x, 0xB1, 0xF, 0xF, true));  x = __float_as_int(v);
    v += __int_as_float(__builtin_amdgcn_update_dpp(0, x, 0x4E, 0xF, 0xF, true));  x = __float_as_int(v);
    v += __int_as_float(__builtin_amdgcn_update_dpp(0, x, 0x141, 0xF, 0xF, true)); x = __float_as_int(v);
    v += __int_as_float(__builtin_amdgcn_update_dpp(0, x, 0x140, 0xF, 0xF, true)); x = __float_as_int(v);
    return (__int_as_float(__builtin_amdgcn_readlane(x, 0)) + __int_as_float(__builtin_amdgcn_readlane(x, 16))) + (__int_as_float(__builtin_amdgcn_readlane(x, 32)) + __int_as_float(__builtin_amdgcn_readlane(x, 48)));
}

#define XB_TMO      128
#define XB_XCNT(j)  (256  + 64 * (j))
#define XB_XSUB(j)  (1280 + 64 * (j))
#define XB_XGEN(j)  (2304 + 64 * (j))
#define XB_TOP      3328
#define XB_TOPGEN   3392
#define XCD_BAR_WORDS 3456
#define XB_SPIN_CAP (1u << 18)
__device__ __forceinline__ unsigned xb_ld(unsigned* p)              { return __hip_atomic_load(p, __ATOMIC_RELAXED, __HIP_MEMORY_SCOPE_AGENT); }
__device__ __forceinline__ unsigned xb_add(unsigned* p, unsigned v) { return __hip_atomic_fetch_add(p, v, __ATOMIC_RELAXED, __HIP_MEMORY_SCOPE_AGENT); }
__device__ __forceinline__ unsigned xb_xcc_id() { return (unsigned)__builtin_amdgcn_s_getreg((3 << 11) | 20) & 0xFu; }
#define XB_SPIN(cond, bar) do { unsigned _sp = 0; while (cond) { __builtin_amdgcn_s_sleep(1); \
    if ((++_sp & 255u) == 0u) { if (xb_ld(&(bar)[XB_TMO])) break; if (_sp > XB_SPIN_CAP) { atomicAdd(&(bar)[XB_TMO], 1u); break; } } } } while (0)
struct XcdBarrier { unsigned* bar; unsigned x; volatile LAS unsigned* st; };
__device__ __forceinline__ XcdBarrier xcd_barrier_post(unsigned* bar, volatile LAS unsigned* st) {
    XcdBarrier b; b.bar = bar; b.x = xb_xcc_id(); b.st = st;
    if (threadIdx.x == 0) (void)xb_add(&bar[XB_XCNT(b.x)], 1u);
    return b;
}
__device__ __forceinline__ void xcd_barrier_complete(unsigned* bar, unsigned x, unsigned& nloc, unsigned& nx) {
    const unsigned G = gridDim.x * gridDim.y * gridDim.z;
    unsigned sum, cnt, mine, sp = 0u;
    for (;;) {
        sum = 0u; cnt = 0u; mine = 0u;
#pragma unroll
        for (unsigned j = 0; j < 16; ++j) { const unsigned c = xb_ld(&bar[XB_XCNT(j)]); sum += c; cnt += (c > 0u) ? 1u : 0u; mine = (j == x) ? c : mine; }
        if (sum == G) break;
        __builtin_amdgcn_s_sleep(1);
        if ((++sp & 255u) == 0u) { if (xb_ld(&bar[XB_TMO])) break; if (sp > XB_SPIN_CAP) { atomicAdd(&bar[XB_TMO], 1u); break; } }
    }
    nloc = mine > 0u ? mine : 1u; nx = cnt > 0u ? cnt : 1u;
}
__device__ __forceinline__ void xcd_barrier(const XcdBarrier& b) {
    asm volatile("s_waitcnt vmcnt(0)" ::: "memory");
    __syncthreads();
    if (threadIdx.x == 0) {
        unsigned* bar = b.bar;
        __builtin_amdgcn_s_waitcnt(0);
        unsigned nloc = b.st[0], nx = b.st[1];
        if (nloc == 0u) { xcd_barrier_complete(bar, b.x, nloc, nx); b.st[0] = nloc; b.st[1] = nx; }
        const unsigned old = xb_add(&bar[XB_XSUB(b.x)], 1u);
        const unsigned gen = old / nloc;
        if (old + 1u == (gen + 1u) * nloc) {
            __builtin_amdgcn_fence(__ATOMIC_RELEASE, "agent");
            asm volatile("s_waitcnt vmcnt(0)" ::: "memory");
            const unsigned og = xb_add(&bar[XB_TOP], 1u);
            const unsigned tg = og / nx;
            if (og + 1u == (tg + 1u) * nx) xb_add(&bar[XB_TOPGEN], 1u);
            else XB_SPIN(xb_ld(&bar[XB_TOPGEN]) == tg, bar);
            __builtin_amdgcn_fence(__ATOMIC_ACQUIRE, "agent");
            xb_add(&bar[XB_XGEN(b.x)], 1u);
            asm volatile("s_waitcnt vmcnt(0)" ::: "memory");
        } else {
            XB_SPIN(xb_ld(&bar[XB_XGEN(b.x)]) == gen, bar);
            __builtin_amdgcn_fence(__ATOMIC_ACQUIRE, "agent");
            asm volatile("s_waitcnt vmcnt(0)" ::: "memory");
        }
    }
    __syncthreads();
}

__device__ __forceinline__ int fresh_lane() { int ln; asm volatile("v_mbcnt_lo_u32_b32 %0, -1, 0\n\tv_mbcnt_hi_u32_b32 %0, -1, %0" : "=&v"(ln)); return ln; }
namespace pg8 {
constexpr int BM = 256, BK = 64, HALF = 128, HTB = HALF * BK * 2, STAGE_BYTES = 8 * HTB, NXCD = 8, WGM = 8;
__host__ __device__ __forceinline__ int lds_byte(int r, int c) { const int st = (r >> 4) * 2 + (c >> 5), rr = r & 15, cc = c & 31, ob = rr * 64 + cc * 2; return st * 1024 + (ob ^ (((ob >> 9) & 1) << 5)); }
__host__ __device__ __forceinline__ void stage_rc(int b, int& R, int& C) { const int st = b / 1024, sb = b % 1024, swz = sb ^ (((sb >> 9) & 1) << 5); R = (st >> 1) * 16 + swz / 64; C = (st & 1) * 32 + (swz % 64) / 2; }
__host__ __device__ __forceinline__ int perm32(int rho) { const int n = rho >> 4, i = rho & 15; return 8 * (i >> 2) + 4 * n + (i & 3); }

struct Unit { int pm, pn, e, rbl, nvalid; };

struct DenseOrder {
    static constexpr bool AOFF_LOADS = false;
    int nM, nN, nwg, G, c, pitch; const char* A; const char* Bt;
    __device__ void init(int M, int N, int pitch_, int G_, int c_, const void* A_, const void* Bt_) { nM = M / BM; nN = N / BM; nwg = nM * nN; G = G_; c = c_; pitch = pitch_; A = (const char*)A_; Bt = (const char*)Bt_; }
    __device__ __forceinline__ bool next(int i, Unit& u) const {
        const long L = (long)i * G + c; if (L >= nwg) return false;
        int wgid = (int)L; { const int q = nwg / NXCD, r = nwg % NXCD, xcd = wgid % NXCD, off = wgid / NXCD; wgid = (xcd < r ? xcd * (q + 1) : r * (q + 1) + (xcd - r) * q) + off; }
        const int nig = WGM * nN, gid = wgid / nig, fm = gid * WGM, gsz = (nM - fm) < WGM ? (nM - fm) : WGM;
        u.pm = fm + ((wgid % nig) % gsz); u.pn = (wgid % nig) / gsz; u.e = 0; u.rbl = 0; u.nvalid = 256; return true;
    }
    __device__ __forceinline__ const char* a_base(const Unit& u) const { return A + (size_t)u.pm * BM * pitch; }
    __device__ __forceinline__ const char* b_base(const Unit& u) const { return Bt + (size_t)u.pn * BM * pitch; }
    __device__ __forceinline__ unsigned a_row_off(const Unit&, int r) const { return (unsigned)(r * pitch); }
};

template <bool GATHER> struct MoeOrder {
    static constexpr bool AOFF_LOADS = GATHER;
    const LAS int* rbs; const LAS int* cnt; const LAS int* ord; int npn, vcu, G, pitch;
    const char* A; const char* Bt; size_t bstride; const unsigned* toklist;
    __device__ __forceinline__ bool next(int i, Unit& u) const {
        const int R = rbs[32], rc = ord[-1], gp = G >> 3, x = vcu / gp, j = i * gp + (vcu % gp);
        const int rbi = j / npn, lo = x * rc, nloc = (lo + rc < R ? lo + rc : R) - lo;
        if (rbi >= nloc) return false;
        const int L = j, rb = ord[lo + rbi]; const int e = ord[352 + rb];
        u.pm = rb; u.pn = L - rbi * npn; u.e = e; u.rbl = rb - rbs[e];
        const int left = cnt[e] - u.rbl * 256; u.nvalid = left < 256 ? left : 256; return true;
    }
    __device__ __forceinline__ const char* a_base(const Unit& u) const { return GATHER ? A : A + (size_t)u.pm * BM * pitch; }
    __device__ __forceinline__ const char* b_base(const Unit& u) const { return Bt + (size_t)u.e * bstride + (size_t)u.pn * BM * pitch; }
    __device__ __forceinline__ unsigned a_row_off(const Unit& u, int r) const {
        if (!GATHER) return (unsigned)(r * pitch);
        const int rc = r < u.nvalid ? r : u.nvalid - 1;
        const unsigned tok = toklist[2 * (unsigned)(u.e * LISTCAP + u.rbl * 256 + rc)];
        return tok * (unsigned)pitch;
    }
};

typedef int i32x4 __attribute__((ext_vector_type(4)));
typedef int i32x8 __attribute__((ext_vector_type(8)));
__device__ __forceinline__ i32x8 cat16(const bf16x8 a, const bf16x8 b) { return __builtin_shufflevector(__builtin_bit_cast(i32x4, a), __builtin_bit_cast(i32x4, b), 0, 1, 2, 3, 4, 5, 6, 7); }
template <class Epi, class Sched, int MODE, bool ALIGN_EPI, int KREP = 1, bool F8 = false, bool LIGHT = false>
__device__ __forceinline__ void gemm_phase(LAS unsigned char* lds, const int tid, const int K, const Sched& S, const Epi& E) {
    const int wid = __builtin_amdgcn_readfirstlane(tid >> 6), lane = tid & 63, wr = wid >> 2, wc = wid & 3, fr = lane & 15, fq = lane >> 4;
    if constexpr (MODE == 9) return;
    const int nt = F8 ? K / 128 : K / BK, pitch = F8 ? K : 2 * K;
    static_assert(!(F8 && MODE == 0), "direct mode is bf16 only");
    f32x4 acc[2][2][4][2];
#define PG8_ZERO_ACC() do { _Pragma("unroll") for (int a = 0; a < 2; ++a) _Pragma("unroll") for (int b = 0; b < 2; ++b) _Pragma("unroll") for (int m = 0; m < 4; ++m) _Pragma("unroll") for (int n = 0; n < 2; ++n) acc[a][b][m][n] = (f32x4){0.f, 0.f, 0.f, 0.f}; } while (0)
    if constexpr (MODE == 0) {
        Unit cur;
#pragma unroll 1
        for (int ui = 0; S.next(ui, cur); ++ui) {
            PG8_ZERO_ACC();
            const char* Ab = S.a_base(cur); const char* Bb = S.b_base(cur);
            unsigned ao[2][4], bo[2][2];
#pragma unroll
            for (int ai = 0; ai < 2; ++ai)
#pragma unroll
                for (int m = 0; m < 4; ++m) ao[ai][m] = S.a_row_off(cur, ai * HALF + wr * 64 + m * 16 + fr) + (unsigned)(fq * 16);
#pragma unroll
            for (int bj = 0; bj < 2; ++bj)
#pragma unroll
                for (int n = 0; n < 2; ++n) { const int rho = n * 16 + fr, brow = bj * HALF + wc * 32 + (Epi::PERM ? perm32(rho) : rho); bo[bj][n] = (unsigned)(brow * pitch + fq * 16); }
#pragma unroll 1
            for (int t2 = 0; t2 < 2 * nt; ++t2) {
                if constexpr (Epi::MID) { if (t2 == nt) { const int ln_ = fresh_lane(); E.mid(acc, cur, wr, wc, ln_ & 15, ln_ >> 4); } }
                {
                    bf16x8 Af[2][4], Bf[2][2];
                    const unsigned ko = (unsigned)(t2 * 64);
#pragma unroll
                    for (int ai = 0; ai < 2; ++ai)
#pragma unroll
                        for (int m = 0; m < 4; ++m) Af[ai][m] = *(const bf16x8*)(Ab + ao[ai][m] + ko);
#pragma unroll
                    for (int bj = 0; bj < 2; ++bj)
#pragma unroll
                        for (int n = 0; n < 2; ++n) Bf[bj][n] = *(const bf16x8*)(Bb + bo[bj][n] + ko);
#pragma unroll
                    for (int ai = 0; ai < 2; ++ai)
#pragma unroll
                        for (int bj = 0; bj < 2; ++bj)
#pragma unroll
                            for (int m = 0; m < 4; ++m)
#pragma unroll
                                for (int n = 0; n < 2; ++n) acc[ai][bj][m][n] = __builtin_amdgcn_mfma_f32_16x16x32_bf16(Bf[bj][n], Af[ai][m], acc[ai][bj][m][n], 0, 0, 0);
                }
            }
            { const int ln_ = fresh_lane(); E(acc, cur, wr, wc, ln_ & 15, ln_ >> 4); }
        }
    } else {
        int Rr[2], Cc[2]; unsigned voffB[2];
#pragma unroll
        for (int i = 0; i < 2; ++i) { stage_rc(tid * 16 + i * 8192, Rr[i], Cc[i]); const int Rb = Epi::PERM ? ((Rr[i] & ~31) + perm32(Rr[i] & 31)) : Rr[i]; voffB[i] = (unsigned)(Rb * pitch + Cc[i] * 2); }
        const size_t kstep = (size_t)(BK * 2);
        const size_t hstep = (size_t)HALF * pitch;
        const unsigned ldsw = (unsigned)wid * 1024u;
        const int aoff = lds_byte(wr * 64 + fr, fq * 8), boff = lds_byte(wc * 32 + fr, fq * 8);
#define PG8_SA(b, h) (((b) * 2 + (h)) * HTB)
#define PG8_SB(b, h) ((4 + (b) * 2 + (h)) * HTB)
#define PG8_STAGE(bufoff, gbase, voff) do { _Pragma("unroll") for (int _i = 0; _i < 2; ++_i) \
        __builtin_amdgcn_global_load_lds((const unsigned*)((const char*)(gbase) + (voff)[_i]), (LAS unsigned*)(lds + (bufoff) + ldsw + _i * 8192), 16, 0, 0); } while (0)
#define PG8_LDA(dst, b, h) do { if constexpr (F8) { _Pragma("unroll") for (int m = 0; m < 4; ++m) { dst##8[m].lo = *(const LAS i32x4*)(lds + PG8_SA(b, h) + aoff + m * 2048); dst##8[m].hi = *(const LAS i32x4*)(lds + PG8_SA(b, h) + aoff + m * 2048 + 1024); } } \
        else { _Pragma("unroll") for (int m = 0; m < 4; ++m) _Pragma("unroll") for (int k = 0; k < 2; ++k) dst[m][k] = *(const LAS bf16x8*)(lds + PG8_SA(b, h) + aoff + m * 2048 + k * 1024); } } while (0)
#define PG8_LDB(dst, b, h) do { if constexpr (F8) { _Pragma("unroll") for (int n = 0; n < 2; ++n) { dst##8[n].lo = *(const LAS i32x4*)(lds + PG8_SB(b, h) + boff + n * 2048); dst##8[n].hi = *(const LAS i32x4*)(lds + PG8_SB(b, h) + boff + n * 2048 + 1024); } } \
        else { _Pragma("unroll") for (int n = 0; n < 2; ++n) _Pragma("unroll") for (int k = 0; k < 2; ++k) dst[n][k] = *(const LAS bf16x8*)(lds + PG8_SB(b, h) + boff + n * 2048 + k * 1024); } } while (0)
#define PG8_MMA(ai, bj, At, Bt) do { __builtin_amdgcn_s_setprio(1); \
        if constexpr (F8) { _Pragma("unroll") for (int m = 0; m < 4; ++m) _Pragma("unroll") for (int n = 0; n < 2; ++n) \
            asm volatile("s_nop 1\n\tv_mfma_scale_f32_16x16x128_f8f6f4 %0, %1, %2, %0, %3, %4 op_sel_hi:[0,0,0]" : "+v"(acc[ai][bj][m][n]) : "v"(Bt##8[n]), "v"(At##8[m]), "v"(sc_w), "v"(sc_x)); } \
        else { _Pragma("unroll") for (int m = 0; m < 4; ++m) _Pragma("unroll") for (int n = 0; n < 2; ++n) _Pragma("unroll") for (int k = 0; k < 2; ++k) \
            acc[ai][bj][m][n] = __builtin_amdgcn_mfma_f32_16x16x32_bf16(Bt[n][k], At[m][k], acc[ai][bj][m][n], 0, 0, 0); } \
        __builtin_amdgcn_s_setprio(0); } while (0)
#define PG8_WAIT_V(n) asm volatile("s_waitcnt vmcnt(" #n ")" ::: "memory")
#define PG8_WAIT_L(n) asm volatile("s_waitcnt lgkmcnt(" #n ")" ::: "memory")
#define PG8_BAR __builtin_amdgcn_s_barrier()
#define PG8_SCHED __builtin_amdgcn_sched_barrier(0)
#define PG8_AOFFS(dst, u) do { _Pragma("unroll") for (int _h = 0; _h < 2; ++_h) _Pragma("unroll") for (int _i = 0; _i < 2; ++_i) dst[_h][_i] = S.a_row_off(u, _h * HALF + Rr[_i]) + (unsigned)(Cc[_i] * 2); } while (0)
        constexpr bool SP2 = (MODE == 2);
        const int sc_w = 122, sc_x = 127;
        Unit cur, nxt; int ui = 0;
        if (!S.next(0, cur)) return;
        PG8_ZERO_ACC();
        bf16x8 At[4][2], B0[2][2], B1[2][2]; i32x8 At8[4], B08[2], B18[2];
        const char* cA = S.a_base(cur); const char* cB = S.b_base(cur);
        unsigned cO[2][2], nO[2][2];
        PG8_AOFFS(cO, cur);
#pragma unroll
        for (int _h = 0; _h < 2; ++_h)
#pragma unroll
            for (int _i = 0; _i < 2; ++_i) nO[_h][_i] = cO[_h][_i];
        if constexpr (SP2) {
            PG8_STAGE(PG8_SB(0, 0), cB, voffB); PG8_STAGE(PG8_SB(0, 1), cB + hstep, voffB); PG8_STAGE(PG8_SA(0, 0), cA, cO[0]); PG8_STAGE(PG8_SA(0, 1), cA, cO[1]);
            if (wr == 1) PG8_BAR;
            PG8_WAIT_V(2); PG8_BAR;
            PG8_STAGE(PG8_SB(1, 0), cB + kstep, voffB); PG8_STAGE(PG8_SA(1, 0), cA + kstep, cO[0]); PG8_STAGE(PG8_SB(1, 1), cB + hstep + kstep, voffB);
            PG8_WAIT_V(6); PG8_BAR;
        } else {
            PG8_STAGE(PG8_SB(0, 0), cB, voffB); PG8_STAGE(PG8_SA(0, 0), cA, cO[0]); PG8_STAGE(PG8_SB(0, 1), cB + hstep, voffB); PG8_STAGE(PG8_SA(0, 1), cA, cO[1]);
            if (wr == 1) PG8_BAR;
            PG8_WAIT_V(4); PG8_BAR;
            PG8_STAGE(PG8_SB(1, 0), cB + kstep, voffB); PG8_STAGE(PG8_SA(1, 0), cA + kstep, cO[0]); PG8_STAGE(PG8_SB(1, 1), cB + hstep + kstep, voffB);
            PG8_WAIT_V(6); PG8_BAR;
        }
        for (;;) {
            const bool has_next = S.next(ui + 1, nxt);
            const bool lightu = LIGHT && cur.nvalid <= 128;
            const char* nA = has_next ? S.a_base(nxt) : cA; const char* nB = has_next ? S.b_base(nxt) : cB;
            if constexpr (!Sched::AOFF_LOADS) { if (has_next) PG8_AOFFS(nO, nxt); }
#pragma unroll 1
            for (int rep = 0; rep < KREP; ++rep)
#pragma unroll 1
            for (int t = 0; t < nt; t += 2) {
                const bool last = (t == nt - 2), lastrep = (rep == KREP - 1), sw = last && lastrep && has_next;
                if constexpr (Epi::MID) { if (t == nt / 2) { if constexpr (F8) asm volatile("s_nop 15\n\ts_nop 3" ::: "memory"); const int ln_ = fresh_lane(); E.mid(acc, cur, wr, wc, ln_ & 15, ln_ >> 4); } }
                if constexpr (Sched::AOFF_LOADS) if (t == 0 && rep == 0 && has_next) PG8_AOFFS(nO, nxt);
                const char* a1 = cA + (size_t)(t + 1) * kstep;
                const char* a2 = last ? (lastrep ? nA : cA) : cA + (size_t)(t + 2) * kstep; const char* b2 = last ? (lastrep ? nB : cB) : cB + (size_t)(t + 2) * kstep;
                const char* a3 = a2 + kstep; const char* b3 = b2 + kstep;
                unsigned o2[2][2];
#pragma unroll
                for (int _h = 0; _h < 2; ++_h)
#pragma unroll
                    for (int _i = 0; _i < 2; ++_i) o2[_h][_i] = sw ? nO[_h][_i] : cO[_h][_i];
                if constexpr (SP2) {
                    PG8_LDB(B0, 0, 0); PG8_LDB(B1, 0, 1); PG8_SCHED; PG8_LDA(At, 0, 0); PG8_STAGE(PG8_SA(1, 1), a1, cO[1]);
                    PG8_WAIT_V(8); PG8_WAIT_L(0); PG8_BAR; PG8_MMA(0, 0, At, B0); PG8_MMA(0, 1, At, B1); PG8_BAR; PG8_SCHED;
                    if (!lightu) PG8_LDA(At, 0, 1); PG8_STAGE(PG8_SB(0, 0), b2, voffB); PG8_STAGE(PG8_SB(0, 1), b2 + hstep, voffB); PG8_STAGE(PG8_SA(0, 0), a2, o2[0]);
                    PG8_WAIT_V(8); PG8_WAIT_L(0); PG8_BAR; if (!lightu) { PG8_MMA(1, 0, At, B0); PG8_MMA(1, 1, At, B1); } PG8_BAR; PG8_SCHED;
                    PG8_LDB(B0, 1, 0); PG8_LDB(B1, 1, 1); PG8_SCHED; PG8_LDA(At, 1, 0); PG8_STAGE(PG8_SA(0, 1), a2, o2[1]);
                    PG8_WAIT_V(8); PG8_WAIT_L(0); PG8_BAR; PG8_MMA(0, 0, At, B0); PG8_MMA(0, 1, At, B1); PG8_BAR; PG8_SCHED;
                    if (!lightu) PG8_LDA(At, 1, 1); PG8_STAGE(PG8_SB(1, 0), b3, voffB); PG8_STAGE(PG8_SB(1, 1), b3 + hstep, voffB); PG8_STAGE(PG8_SA(1, 0), a3, o2[0]);
                    PG8_WAIT_V(8); PG8_WAIT_L(0); PG8_BAR; if (!lightu) { PG8_MMA(1, 0, At, B0); PG8_MMA(1, 1, At, B1); } PG8_BAR; PG8_SCHED;
                } else {
                    PG8_LDB(B0, 0, 0); PG8_SCHED; PG8_LDA(At, 0, 0); PG8_STAGE(PG8_SA(1, 1), a1, cO[1]);
                    PG8_WAIT_L(8); PG8_BAR; PG8_WAIT_L(0); PG8_MMA(0, 0, At, B0); PG8_BAR; PG8_SCHED;
                    PG8_LDB(B1, 0, 1); PG8_STAGE(PG8_SB(0, 0), b2, voffB);
                    PG8_BAR; PG8_WAIT_L(0); PG8_MMA(0, 1, At, B1); PG8_BAR;
                    PG8_LDA(At, 0, 1); PG8_STAGE(PG8_SA(0, 0), a2, o2[0]);
                    PG8_BAR; PG8_WAIT_L(0); PG8_MMA(1, 0, At, B0); PG8_BAR; PG8_SCHED;
                    PG8_STAGE(PG8_SB(0, 1), b2 + hstep, voffB);
                    PG8_WAIT_V(6); PG8_BAR; PG8_MMA(1, 1, At, B1); PG8_BAR;
                    PG8_LDB(B0, 1, 0); PG8_SCHED; PG8_LDA(At, 1, 0); PG8_STAGE(PG8_SA(0, 1), a2, o2[1]);
                    PG8_WAIT_L(8); PG8_BAR; PG8_WAIT_L(0); PG8_MMA(0, 0, At, B0); PG8_BAR; PG8_SCHED;
                    PG8_LDB(B1, 1, 1); PG8_STAGE(PG8_SB(1, 0), b3, voffB);
                    PG8_BAR; PG8_WAIT_L(0); PG8_MMA(0, 1, At, B1); PG8_BAR;
                    PG8_LDA(At, 1, 1); PG8_STAGE(PG8_SA(1, 0), a3, o2[0]);
                    PG8_BAR; PG8_WAIT_L(0); PG8_MMA(1, 0, At, B0); PG8_BAR; PG8_SCHED;
                    PG8_STAGE(PG8_SB(1, 1), b3 + hstep, voffB);
                    PG8_WAIT_V(6); PG8_BAR; PG8_MMA(1, 1, At, B1); PG8_BAR;
                }
            }
            if constexpr (ALIGN_EPI) { if (wr == 0) PG8_BAR; }
            if constexpr (F8) asm volatile("s_nop 15\n\ts_nop 3" ::: "memory");
            if constexpr (KREP > 1) { _Pragma("unroll") for (int a = 0; a < 2; ++a) _Pragma("unroll") for (int b = 0; b < 2; ++b) _Pragma("unroll") for (int m = 0; m < 4; ++m) _Pragma("unroll") for (int n = 0; n < 2; ++n) acc[a][b][m][n] *= (1.0f / KREP); }
            { const int ln_ = fresh_lane(); E(acc, cur, wr, wc, ln_ & 15, ln_ >> 4); }
            if (!has_next) break;
            PG8_ZERO_ACC();
            cur = nxt; cA = nA; cB = nB; ++ui;
#pragma unroll
            for (int _h = 0; _h < 2; ++_h)
#pragma unroll
                for (int _i = 0; _i < 2; ++_i) cO[_h][_i] = nO[_h][_i];
            if constexpr (ALIGN_EPI) { if (wr == 1) PG8_BAR; }
        }
        PG8_WAIT_V(0);
        if constexpr (!ALIGN_EPI) { if (wr == 0) PG8_BAR; }
        PG8_BAR;
#undef PG8_SA
#undef PG8_SB
#undef PG8_STAGE
#undef PG8_LDA
#undef PG8_LDB
#undef PG8_MMA
#undef PG8_WAIT_V
#undef PG8_WAIT_L
#undef PG8_BAR
#undef PG8_SCHED
#undef PG8_AOFFS
    }
#undef PG8_ZERO_ACC
}
}

using pg8::Unit;
typedef f32x4 AccT[2][2][4][2];
__device__ __forceinline__ int launder_v(int x) { asm volatile("" : "+v"(x)); return x; }
__device__ __forceinline__ u32x4 pack8(const f32x4 a, const f32x4 b) { u32x4 w; w.x = cvt_pk_bf16(a[0], a[1]); w.y = cvt_pk_bf16(a[2], a[3]); w.z = cvt_pk_bf16(b[0], b[1]); w.w = cvt_pk_bf16(b[2], b[3]); return w; }
__device__ __forceinline__ void st16(char* p, const u32x4 v) { if (NT_STORE) __builtin_nontemporal_store(v, (u32x4*)p); else *(u32x4*)p = v; }
__device__ __forceinline__ f32x4 unlo(const u32x4 g) { return (f32x4){bflo(g.x), bfhi(g.x), bflo(g.y), bfhi(g.y)}; }
__device__ __forceinline__ f32x4 unhi(const u32x4 g) { return (f32x4){bflo(g.z), bfhi(g.z), bflo(g.w), bfhi(g.w)}; }

struct EpiInProj {
    static constexpr bool PERM = true, MID = false;
    unsigned char* ws; const float* bgate; int pn0;
    __device__ __forceinline__ void mid(AccT&, const Unit&, int, int, int, int) const {}
    __device__ __forceinline__ void operator()(const AccT& acc, const Unit& u, int wr, int wc, int fr, int fq) const {
        const int row0 = launder_v(u.pm * 256 + wr * 64 + fr), pn = u.pn + pn0, cl = wc * 32 + 8 * fq;
        if (pn < 8) {
            char* XC = (char*)(ws + WS_XC); const unsigned o0 = ((unsigned)row0 * CW + pn * 128 + cl) * 2u;
#pragma unroll
            for (int ai = 0; ai < 2; ++ai)
#pragma unroll
                for (int m = 0; m < 4; ++m)
                    st16(XC + o0 + (unsigned)((ai * 128 + m * 16) * CW * 2), pack8(acc[ai][0][m][0] * acc[ai][1][m][0], acc[ai][0][m][1] * acc[ai][1][m][1]));
        } else if (pn < 20) {
            const int kind = (pn - 8) >> 2, q = (pn - 8) & 3;
            char* dst = (char*)(ws + (kind == 0 ? WS_BB : (kind == 1 ? WS_U : WS_V))); const unsigned o0 = ((unsigned)row0 * CW + q * 256 + cl) * 2u;
            char* VST = (char*)(ws + WS_VSTAT); const unsigned so = ((unsigned)row0 * 16 + q * 4 + wc) * 8u;
#pragma unroll
            for (int ai = 0; ai < 2; ++ai)
#pragma unroll
                for (int m = 0; m < 4; ++m) { float s = 0.f, sq = 0.f;
#pragma unroll
                    for (int bj = 0; bj < 2; ++bj) { f32x4 v0 = acc[ai][bj][m][0], v1 = acc[ai][bj][m][1];
                        if (kind != 0) { v0 = gelu_tanh4(v0); v1 = gelu_tanh4(v1); }
                        if (kind == 2) {
#pragma unroll
                            for (int j = 0; j < 4; ++j) { s += v0[j] + v1[j]; sq += v0[j] * v0[j] + v1[j] * v1[j]; } }
                        st16(dst + o0 + (unsigned)(((ai * 128 + m * 16) * CW + bj * 128) * 2), pack8(v0, v1)); }
                    if (kind == 2) { s += __shfl_xor(s, 16); s += __shfl_xor(s, 32); sq += __shfl_xor(sq, 16); sq += __shfl_xor(sq, 32);
                        if (fq == 0) *(f32x2*)(VST + so + (unsigned)((ai * 128 + m * 16) * 16 * 8)) = (f32x2){s, sq}; }
                    asm volatile("" ::: "memory"); }
        } else {
            const int d0 = (pn - 20) * 128 + cl;
            char* GR = (char*)(ws + WS_GR); char* GB = (char*)(ws + WS_GB); const unsigned o0 = ((unsigned)((u.pm * 16 + (pn - 20)) * 8 + wr * 4 + wc) * 8u) * 1024u + (unsigned)launder_v(fq * 16 + fr) * 16u;
            f32x4 ba[2], bb[2]; const float NL2E = -1.44269504f, CL = 43.2808512f;
#pragma unroll
            for (int n = 0; n < 2; ++n) { ba[n] = *(const f32x4*)(bgate + d0 + 4 * n) * NL2E; bb[n] = *(const f32x4*)(bgate + D + d0 + 4 * n) * NL2E; }
#pragma unroll
            for (int ai = 0; ai < 2; ++ai)
#pragma unroll
                for (int m = 0; m < 4; ++m) { f32x4 r[2], sb[2];
#pragma unroll
                    for (int n = 0; n < 2; ++n) {
                        f32x4 xa = acc[ai][0][m][n] * NL2E + ba[n], xb = acc[ai][1][m][n] * NL2E + bb[n], ta, tb;
#pragma unroll
                        for (int j = 0; j < 4; ++j) { ta[j] = __builtin_amdgcn_exp2f(__builtin_amdgcn_fmed3f(xa[j], -CL, CL)); tb[j] = __builtin_amdgcn_exp2f(__builtin_amdgcn_fmed3f(xb[j], -CL, CL)); }
                        ta = ta + 1.0f; tb = tb + 1.0f;
                        f32x4 inv = ta * tb;
#pragma unroll
                        for (int j = 0; j < 4; ++j) inv[j] = __builtin_amdgcn_rcpf(inv[j]);
                        sb[n] = ta * (inv * 255.f); r[n] = tb * tb * inv; }
                    const unsigned o = o0 + (unsigned)((ai * 4 + m) * 1024);
                    st16(GR + o, pack8(r[0], r[1]));
                    unsigned q0 = 0u, q1 = 0u;
#pragma unroll
                    for (int j = 0; j < 4; ++j) { q0 = __builtin_amdgcn_cvt_pk_u8_f32(sb[0][j], j, q0); q1 = __builtin_amdgcn_cvt_pk_u8_f32(sb[1][j], j, q1); }
                    *(u32x2*)(GB + (o >> 1)) = (u32x2){q0, q1};
                    asm volatile("" ::: "memory"); }
        }
    }
};

struct EpiBranch {
    static constexpr bool PERM = true, MID = true;
    unsigned char* ws; bool f8out;
    __device__ __forceinline__ void mid(AccT& acc, const Unit& u, int wr, int wc, int fr, int fq) const {
        const char* GR = (const char*)(ws + WS_GR);
        const unsigned o0 = ((unsigned)((u.pm * 16 + 2 * u.pn) * 8 + wr * 4 + wc) * 8u) * 1024u + (unsigned)launder_v(fq * 16 + fr) * 16u;
        u32x4 g[2][4][2];
#pragma unroll
        for (int ai = 0; ai < 2; ++ai)
#pragma unroll
            for (int m = 0; m < 4; ++m)
#pragma unroll
                for (int bj = 0; bj < 2; ++bj) g[ai][m][bj] = *(const u32x4*)(GR + o0 + (unsigned)(bj * 65536 + (ai * 4 + m) * 1024));
#pragma unroll
        for (int ai = 0; ai < 2; ++ai)
#pragma unroll
            for (int m = 0; m < 4; ++m)
#pragma unroll
                for (int bj = 0; bj < 2; ++bj) { acc[ai][bj][m][0] *= unlo(g[ai][m][bj]); acc[ai][bj][m][1] *= unhi(g[ai][m][bj]); }
    }
    __device__ __forceinline__ void operator()(const AccT& acc, const Unit& u, int wr, int wc, int fr, int fq) const {
        const int row0 = launder_v(u.pm * 256 + wr * 64 + fr); const char* GB = (const char*)(ws + WS_GB); char* OUT = (char*)(ws + WS_XN);
        const unsigned o0 = ((unsigned)row0 * D + u.pn * 256 + wc * 32 + 8 * fq);
        const unsigned g0 = ((unsigned)((u.pm * 16 + 2 * u.pn) * 8 + wr * 4 + wc) * 8u) * 1024u + (unsigned)(fq * 16 + fr) * 16u;
        u32x2 g[2][4][2];
#pragma unroll
        for (int ai = 0; ai < 2; ++ai)
#pragma unroll
            for (int m = 0; m < 4; ++m)
#pragma unroll
                for (int bj = 0; bj < 2; ++bj) g[ai][m][bj] = *(const u32x2*)(GB + ((g0 + (unsigned)(bj * 65536 + (ai * 4 + m) * 1024)) >> 1));
#pragma unroll
        for (int ai = 0; ai < 2; ++ai)
#pragma unroll
            for (int m = 0; m < 4; ++m)
#pragma unroll
                for (int bj = 0; bj < 2; ++bj) { const unsigned o = o0 + (unsigned)((ai * 128 + m * 16) * D + bj * 128);
                    const unsigned ga = g[ai][m][bj].x, gb = g[ai][m][bj].y; const float k255 = 1.0f / 255.f;
                    const f32x4 v0 = acc[ai][bj][m][0] * ((f32x4){(float)(ga & 255u), (float)((ga >> 8) & 255u), (float)((ga >> 16) & 255u), (float)(ga >> 24)} * k255),
                                v1 = acc[ai][bj][m][1] * ((f32x4){(float)(gb & 255u), (float)((gb >> 8) & 255u), (float)((gb >> 16) & 255u), (float)(gb >> 24)} * k255);
                    if (f8out) *(u32x2*)(OUT + o) = (u32x2){pk4_fp8(v0[0], v0[1], v0[2], v0[3]), pk4_fp8(v1[0], v1[1], v1[2], v1[3])};
                    else *(u32x4*)(OUT + 2u * o) = pack8(v0, v1); }
    }
};

struct EpiOut {
    static constexpr bool PERM = true, MID = false;
    unsigned char* ws;
    __device__ __forceinline__ void mid(AccT&, const Unit&, int, int, int, int) const {}
    __device__ __forceinline__ void operator()(const AccT& acc, const Unit& u, int wr, int wc, int fr, int fq) const {
        const int row0 = launder_v(u.pm * 256 + wr * 64 + fr); char* Y = (char*)(ws + WS_DELTA);
        const unsigned o0 = ((unsigned)row0 * D + u.pn * 256 + wc * 32 + 8 * fq) * 2u;
#pragma unroll
        for (int ai = 0; ai < 2; ++ai)
#pragma unroll
            for (int m = 0; m < 4; ++m) {
#pragma unroll
                for (int bj = 0; bj < 2; ++bj) *(u32x4*)(Y + o0 + (unsigned)(((ai * 128 + m * 16) * D + bj * 128) * 2)) = pack8(acc[ai][bj][m][0], acc[ai][bj][m][1]);
                asm volatile("" ::: "memory"); }
    }
};

struct EpiGU {
    static constexpr bool PERM = true, MID = false;
    unsigned char* ws;
    __device__ __forceinline__ void mid(AccT&, const Unit&, int, int, int, int) const {}
    __device__ __forceinline__ void operator()(const AccT& acc, const Unit& u, int wr, int wc, int fr, int fq) const {
        const int rl0 = launder_v(wr * 64 + fr); const int row0 = u.pm * 256 + rl0; char* HM = (char*)(ws + WS_HMID);
        const char* RL = (const char*)(ws + WS_TOKLIST); const unsigned rb0 = (unsigned)(u.e * LISTCAP + u.rbl * 256) * 8u + 4u; const int vmax = u.nvalid - 1;
        const unsigned o0 = ((unsigned)row0 * DE + u.pn * 128 + wc * 32 + 8 * fq);
        float rsv[2][4];
#pragma unroll
        for (int ai = 0; ai < 2; ++ai)
#pragma unroll
            for (int m = 0; m < 4; ++m) { int rl = rl0 + ai * 128 + m * 16; rl = rl < vmax ? rl : vmax;
                rsv[ai][m] = *(const float*)(RL + rb0 + (unsigned)rl * 8u); }
#pragma unroll
        for (int ai = 0; ai < 2; ++ai)
#pragma unroll
            for (int m = 0; m < 4; ++m) { const float rs = rsv[ai][m];
                f32x4 h[2];
#pragma unroll
                for (int n = 0; n < 2; ++n) { const f32x4 g = acc[ai][0][m][n] * rs, up = acc[ai][1][m][n] * rs, z = g * -1.44269504f; f32x4 t;
#pragma unroll
                    for (int j = 0; j < 4; ++j) t[j] = __builtin_amdgcn_exp2f(z[j]);
                    t = t + 1.0f;
#pragma unroll
                    for (int j = 0; j < 4; ++j) t[j] = __builtin_amdgcn_rcpf(t[j]);
                    h[n] = (g * t) * up; }
                *(u32x2*)(HM + o0 + (unsigned)((ai * 128 + m * 16) * DE)) = (u32x2){pk4_fp8(h[0][0], h[0][1], h[0][2], h[0][3]), pk4_fp8(h[1][0], h[1][1], h[1][2], h[1][3])};
                asm volatile("" ::: "memory"); }
    }
};

struct EpiDown {
    static constexpr bool PERM = true, MID = false;
    unsigned char* ws; bool f8out;
    __device__ __forceinline__ void mid(AccT&, const Unit&, int, int, int, int) const {}
    __device__ __forceinline__ void operator()(const AccT& acc, const Unit& u, int wr, int wc, int fr, int fq) const {
        const int row0 = launder_v(u.pm * 256 + wr * 64 + fr); char* Y = (char*)(ws + WS_YSLOT);
        const unsigned o0 = ((unsigned)row0 * D + u.pn * 256 + wc * 32 + 8 * fq);
#pragma unroll
        for (int ai = 0; ai < 2; ++ai)
#pragma unroll
            for (int m = 0; m < 4; ++m) {
#pragma unroll
                for (int bj = 0; bj < 2; ++bj) { const unsigned o = o0 + (unsigned)((ai * 128 + m * 16) * D + bj * 128);
                    if (f8out) { f32x4 v0 = acc[ai][bj][m][0] * 16.f, v1 = acc[ai][bj][m][1] * 16.f;
#pragma unroll
                        for (int j = 0; j < 4; ++j) { v0[j] = __builtin_amdgcn_fmed3f(v0[j], -448.f, 448.f); v1[j] = __builtin_amdgcn_fmed3f(v1[j], -448.f, 448.f); }
                        *(u32x2*)(Y + o) = (u32x2){pk4_fp8(v0[0], v0[1], v0[2], v0[3]), pk4_fp8(v1[0], v1[1], v1[2], v1[3])}; }
                    else *(u32x4*)(Y + 2u * o) = pack8(acc[ai][bj][m][0], acc[ai][bj][m][1]); }
                asm volatile("" ::: "memory"); }
    }
};

struct Args { const float* in[20]; float* out; unsigned char* ws; };
#define CAS __attribute__((address_space(4)))
typedef const CAS unsigned char* kptr_t;
__device__ __forceinline__ const float* arg_in(kptr_t kp, int i) { const GAS float* p = *(const GAS float* const CAS*)(kp + 8 * i); return (const float*)p; }
__device__ __forceinline__ float* arg_out(kptr_t kp) { GAS float* p = *(GAS float* const CAS*)(kp + 160); return (float*)p; }
__device__ __forceinline__ unsigned char* arg_ws(kptr_t kp) { GAS unsigned char* p = *(GAS unsigned char* const CAS*)(kp + 168); return (unsigned char*)p; }
struct Frame {
    LAS unsigned char* lds; volatile LAS unsigned* MISC; unsigned* ctl;
    int tid, lane, wave, vcu, G;
    kptr_t kp; float* out; unsigned char* ws;
};
__device__ __forceinline__ int launder_s(int x) { asm volatile("" : "+s"(x)); return x; }
__device__ __forceinline__ kptr_t launder_k(kptr_t p) { asm volatile("" : "+s"(p)); return p; }
__device__ __forceinline__ void phase_frame(const struct Frame& F, struct Frame& P);
enum { I_X = 0, I_N1G, I_WIN, I_BGATE, I_CONVW, I_LNVG, I_LNVB, I_SGUW, I_SGUB, I_WBR, I_WOUT, I_N2G, I_RG, I_RGB, I_RE, I_REB, I_WGATE, I_WUP, I_WDOWN, I_FG };

__device__ __forceinline__ void phase_frame(const Frame& F, Frame& P) {
    P = F; P.wave = launder_s(F.wave); { int ln_; asm volatile("v_mbcnt_lo_u32_b32 %0, -1, 0\n\tv_mbcnt_hi_u32_b32 %0, -1, %0" : "=&v"(ln_)); P.lane = ln_; } P.tid = P.wave * 64 + P.lane;     P.kp = launder_k(F.kp); P.ws = arg_ws(P.kp); P.out = arg_out(P.kp); P.ctl = (unsigned*)(P.ws + WS_CTL); P.vcu = launder_s(F.vcu);
}
__device__ __forceinline__ int win_map(int n0) {
    if (n0 < 1024) return 256 * (n0 >> 7) + (n0 & 127);
    if (n0 < 2048) return 256 * 8 + (n0 - 1024);
    if (n0 < 3072) { const int j = n0 - 2048; return 256 * (j >> 7) + 128 + (j & 127); }
    if (n0 < 4096) return 256 * 12 + (n0 - 3072);
    if (n0 < 5120) return 256 * 16 + (n0 - 4096);
    if (n0 < 7168) { const int d = n0 - 5120; return 256 * 20 + 256 * (d >> 7) + (d & 127); }
    { const int d = n0 - 7168; return 256 * 20 + 256 * (d >> 7) + 128 + (d & 127); }
}
struct TrItem { const float* src; bf16* dst; int N, ldk, kcol0, k0, n0, drow0, f8; };
constexpr int IT_WIN = 32 * 144, IT_WBR = 16 * 32, IT_WOUT = 32 * 32, IT_EXP = 256, IT_LAYER = IT_WIN + 2 * IT_WBR + IT_WOUT + 3 * 32 * IT_EXP, IT_TOTAL = DEPTH * IT_LAYER;
__device__ __forceinline__ void p0_decode(const Frame& F, int it, TrItem& t) {
    const int l = it / IT_LAYER; int r = it - l * IT_LAYER;
    unsigned char* ws = F.ws;
    if (r < IT_WIN) { const int kb = r / 144, nb = r - kb * 144; t.src = arg_in(F.kp, I_WIN) + (size_t)l * D * DIN; t.N = DIN; t.ldk = D; t.kcol0 = 0; t.k0 = kb * 64; t.n0 = nb * 64;
        const int dr = win_map(nb * 64), split = l >= G1_F8_FROM ? G1_SPLIT : 5120;
        if (dr < split) { t.dst = (bf16*)(ws + WS_WIN) + (size_t)l * DIN * D; t.drow0 = dr; t.f8 = 0; }
        else { t.dst = (bf16*)(ws + WS_WIN8 + (size_t)l * 6144 * D); t.drow0 = dr - split; t.f8 = 1; }
        return; }
    r -= IT_WIN;
    if (r < 2 * IT_WBR) { const int br = r / IT_WBR; r -= br * IT_WBR; const int kb = r >> 5, nb = r & 31; t.src = arg_in(F.kp, I_WBR) + (size_t)(l * 2 + br) * CW * D; t.N = D; t.dst = (bf16*)(ws + WS_WBR) + (size_t)l * D * D; t.ldk = D; t.kcol0 = br * CW; t.k0 = kb * 64; t.n0 = nb * 64; t.drow0 = nb * 64; t.f8 = (l >= G2_F8_FROM); return; }
    r -= 2 * IT_WBR;
    if (r < IT_WOUT) { const int kb = r >> 5, nb = r & 31; t.src = arg_in(F.kp, I_WOUT) + (size_t)l * D * D; t.N = D; t.dst = (bf16*)(ws + WS_WOUT) + (size_t)l * D * D; t.ldk = D; t.kcol0 = 0; t.k0 = kb * 64; t.n0 = nb * 64; t.drow0 = nb * 64; t.f8 = (l >= G3_F8_FROM); return; }
    r -= IT_WOUT;
    const int type = r / (32 * IT_EXP); r -= type * 32 * IT_EXP; const int e = r / IT_EXP; r -= e * IT_EXP;
    if (type < 2) { const int kb = r >> 3, nb = r & 7, n0 = nb * 64; t.src = (type == 0 ? arg_in(F.kp, I_WGATE) : arg_in(F.kp, I_WUP)) + (size_t)(l * NE + e) * D * DE; t.N = DE; t.dst = (bf16*)(ws + WS_WGU + (size_t)(l * NE + e) * 1024 * D); t.ldk = D; t.kcol0 = 0; t.k0 = kb * 64; t.n0 = n0; t.f8 = 1;
        t.drow0 = 256 * (n0 >> 7) + (type == 1 ? 128 : 0) + (n0 & 127); return; }
    { const int kb = r >> 5, nb = r & 31; t.src = arg_in(F.kp, I_WDOWN) + (size_t)(l * NE + e) * DE * D; t.N = D; t.dst = (bf16*)(ws + WS_WD + (size_t)(l * NE + e) * D * DE); t.ldk = DE; t.kcol0 = 0; t.k0 = kb * 64; t.n0 = nb * 64; t.drow0 = nb * 64; t.f8 = 1; }
}
__device__ __forceinline__ void p0_load(const TrItem& t, int lane, float (&v)[64]) {
    const float* p = t.src + (size_t)t.k0 * t.N + t.n0 + lane;
#pragma unroll
    for (int i = 0; i < 64; ++i) v[i] = __builtin_nontemporal_load(p + (size_t)i * t.N);
}

__device__ __forceinline__ f32x4 ydec_lo(const u32x4 y) { return unlo(y); }
__device__ __forceinline__ f32x4 ydec_hi(const u32x4 y) { return unhi(y); }
__device__ __forceinline__ f32x4 ydec_lo(const u32x2 y) { const f32x2 a = __builtin_amdgcn_cvt_pk_f32_fp8((int)y.x, false), b = __builtin_amdgcn_cvt_pk_f32_fp8((int)y.x, true); return (f32x4){a.x, a.y, b.x, b.y}; }
__device__ __forceinline__ f32x4 ydec_hi(const u32x2 y) { const f32x2 a = __builtin_amdgcn_cvt_pk_f32_fp8((int)y.y, false), b = __builtin_amdgcn_cvt_pk_f32_fp8((int)y.y, true); return (f32x4){a.x, a.y, b.x, b.y}; }
template <bool Y8> struct YRow { typedef u32x4 T; };
template <> struct YRow<true> { typedef u32x2 T; };
template <int MODE> __device__ __forceinline__ void row_pass(const Frame& F, const float* gain) {
    const int lane = F.lane; const int gw = F.wave * F.G + F.vcu, NGW = F.G * NWAVES;
    const float* src = arg_in(F.kp, I_X); const bf16* Hs = (const bf16*)(F.ws + (MODE == 2 ? WS_H1 : WS_H)); bf16* Hd = (bf16*)(F.ws + (MODE == 0 ? WS_H : WS_H1));
    const bf16* DL = (const bf16*)(F.ws + WS_DELTA);
    bf16* XN = (bf16*)(F.ws + WS_XN);
    constexpr bool Y8 = (MODE == 2 ? DEPTH - 1 : 0) >= YS_F8_FROM;
    typedef typename YRow<Y8>::T YT; constexpr int YB = Y8 ? 1 : 2;
    const unsigned char* Y = F.ws + WS_YSLOT; const float ysc = Y8 ? 0.0625f : 1.0f;
    const LAS int* rbs = (const LAS int*)(F.lds + MISC_OFF + 64);
    f32x4 g[4][2];
#pragma unroll
    for (int j = 0; j < 4; ++j) { g[j][0] = *(const f32x4*)(gain + 512 * j + 8 * lane); g[j][1] = *(const f32x4*)(gain + 512 * j + 8 * lane + 4); }
    f32x4 hA[4][2], hB[4][2]; u32x4 rA[4], rB[4]; u32x4 dA[4], dB[4]; YT yA0[4], yA1[4], yB0[4], yB1[4]; f32x2 wA = (f32x2){0.f, 0.f}, wB = (f32x2){0.f, 0.f};
    u32x4 rec = (u32x4){0u, 0u, 0u, 0u}; f32x2 recw = (f32x2){0.f, 0.f};
#define RP_REC(row_) do { if (MODE != 0 && (row_) < NTOK) { rec = *(const u32x4*)(F.ws + WS_TOKINFO + (size_t)(row_) * 32); recw = *(const f32x2*)(F.ws + WS_TOKINFO + (size_t)(row_) * 32 + 16); } } while (0)
#define RP_LOAD(h_, r_, d_, y0_, y1_, w_, row_) do { if ((row_) < NTOK) { \
        _Pragma("unroll") for (int j = 0; j < 4; ++j) { \
            if constexpr (MODE == 0) { h_[j][0] = *(const f32x4*)(src + (size_t)(row_) * D + 512 * j + 8 * lane); h_[j][1] = *(const f32x4*)(src + (size_t)(row_) * D + 512 * j + 8 * lane + 4); } \
            else r_[j] = *(const u32x4*)(Hs + (size_t)(row_) * D + 512 * j + 8 * lane); } \
        if constexpr (MODE != 0) { const int s0 = 256 * rbs[rec.x] + (int)rec.y, s1 = 256 * rbs[rec.z] + (int)rec.w; w_ = recw * ysc; \
            _Pragma("unroll") for (int j = 0; j < 4; ++j) { d_[j] = *(const u32x4*)(DL + (size_t)(row_) * D + 512 * j + 8 * lane); \
                y0_[j] = *(const YT*)(Y + ((size_t)s0 * D + 512 * j + 8 * lane) * YB); y1_[j] = *(const YT*)(Y + ((size_t)s1 * D + 512 * j + 8 * lane) * YB); } } } } while (0)
#define RP_DO(h_, r_, d_, y0_, y1_, w_, row_) do { \
        if constexpr (MODE != 0) { _Pragma("unroll") for (int j = 0; j < 4; ++j) { \
            h_[j][0] = unlo(r_[j]) + unlo(d_[j]) + w_.x * ydec_lo(y0_[j]) + w_.y * ydec_lo(y1_[j]); h_[j][1] = unhi(r_[j]) + unhi(d_[j]) + w_.x * ydec_hi(y0_[j]) + w_.y * ydec_hi(y1_[j]); } } \
        float ss = 0.f; \
        _Pragma("unroll") for (int j = 0; j < 4; ++j) _Pragma("unroll") for (int q = 0; q < 2; ++q) ss += (h_[j][q][0] * h_[j][q][0] + h_[j][q][1] * h_[j][q][1]) + (h_[j][q][2] * h_[j][q][2] + h_[j][q][3] * h_[j][q][3]); \
        const float rstd = 1.0f / sqrtf(wave_sum(ss) * (1.0f / D) + EPS); \
        _Pragma("unroll") for (int j = 0; j < 4; ++j) { \
            if constexpr (MODE != 2) *(u32x4*)(Hd + (size_t)(row_) * D + 512 * j + 8 * lane) = pack8(h_[j][0], h_[j][1]); \
            const f32x4 o0 = h_[j][0] * rstd * g[j][0], o1 = h_[j][1] * rstd * g[j][1]; \
            if constexpr (MODE == 2) { *(f32x4*)(F.out + (size_t)(row_) * D + 512 * j + 8 * lane) = o0; *(f32x4*)(F.out + (size_t)(row_) * D + 512 * j + 8 * lane + 4) = o1; } \
            else { *(u32x4*)(XN + (size_t)(row_) * D + 512 * j + 8 * lane) = pack8(o0, o1); \
                *(u32x2*)(F.ws + WS_XN8 + (size_t)(row_) * D + 512 * j + 8 * lane) = (u32x2){pk4_fp8(o0[0], o0[1], o0[2], o0[3]), pk4_fp8(o1[0], o1[1], o1[2], o1[3])}; } } } while (0)
    RP_REC(gw);
    RP_LOAD(hA, rA, dA, yA0, yA1, wA, gw);
    RP_REC(gw + NGW);
#pragma unroll 1
    for (int row = gw; row < NTOK; row += 2 * NGW) {
        RP_LOAD(hB, rB, dB, yB0, yB1, wB, row + NGW);
        RP_REC(row + 2 * NGW);
        RP_DO(hA, rA, dA, yA0, yA1, wA, row);
        if (row + NGW < NTOK) {
            RP_LOAD(hA, rA, dA, yA0, yA1, wA, row + 2 * NGW);
            RP_REC(row + 3 * NGW);
            RP_DO(hB, rB, dB, yB0, yB1, wB, row + NGW);
        }
    }
#undef RP_REC
#undef RP_LOAD
#undef RP_DO
}

template <int PM  > __device__ __forceinline__ void p0_prologue(const Frame& F) {
    LAS float* scr = (LAS float*)(F.lds + F.wave * P0_SCR);
    const int lane = F.lane, gw = F.vcu * NWAVES + F.wave, NGW = F.G * NWAVES;
    {
        TrItem cur, nxt; float v[64];
        int it = gw; bool have = it < IT_TOTAL;
        if (have) { p0_decode(F, it, cur); p0_load(cur, lane, v); }
#pragma unroll 1
        while (have) {
#pragma unroll
            for (int i = 0; i < 64; ++i) scr[i * 65 + lane] = v[i];
            LDS_WAIT(); asm volatile("" ::: "memory");
            const int itn = it + NGW; const bool haven = itn < IT_TOTAL;
            if (haven) { p0_decode(F, itn, nxt); p0_load(nxt, lane, v); }
            const int c = lane & 7;
#pragma unroll
            for (int j = 0; j < 8; ++j) { const int n = (lane >> 3) + 8 * j; const LAS float* s = scr + (8 * c) * 65 + n;
                const size_t eo = (size_t)(cur.drow0 + n) * cur.ldk + cur.kcol0 + cur.k0 + 8 * c;
                if (cur.f8) { u32x2 o; o.x = pk4_fp8(32.f * s[0 * 65], 32.f * s[1 * 65], 32.f * s[2 * 65], 32.f * s[3 * 65]); o.y = pk4_fp8(32.f * s[4 * 65], 32.f * s[5 * 65], 32.f * s[6 * 65], 32.f * s[7 * 65]);
                    __builtin_nontemporal_store(o, (u32x2*)((unsigned char*)cur.dst + eo)); }
                else { u32x4 o; o.x = cvt_pk_bf16(s[0 * 65], s[1 * 65]); o.y = cvt_pk_bf16(s[2 * 65], s[3 * 65]); o.z = cvt_pk_bf16(s[4 * 65], s[5 * 65]); o.w = cvt_pk_bf16(s[6 * 65], s[7 * 65]);
                    __builtin_nontemporal_store(o, (u32x4*)(cur.dst + eo)); } }
            LDS_WAIT(); asm volatile("" ::: "memory");
            cur = nxt; it = itn; have = haven;
        }
    }
    if (PM == 0) {
        bf16* RT = (bf16*)(F.ws + WS_RT);
        for (int idx = (F.vcu * NWAVES + F.wave) * 64 + lane; idx < DEPTH * 48 * D; idx += NGW * 64) {
            const int l = idx / (48 * D), r = idx - l * 48 * D, e = r / D, k = r - e * D;
            float w = 0.f; if (e < 4) w = arg_in(F.kp, I_RG)[(size_t)(l * D + k) * NGRP + e]; else if (e < 36) w = arg_in(F.kp, I_RE)[(size_t)(l * D + k) * NE + (e - 4)];
            const unsigned hi = cvt_pk_bf16(w, 0.f) & 0xffffu; const float rem = w - __uint_as_float(hi << 16); const unsigned lo = cvt_pk_bf16(rem, 0.f) & 0xffffu;
            RT[(size_t)(l * 2 + 0) * 48 * D + r] = (bf16)hi; RT[(size_t)(l * 2 + 1) * 48 * D + r] = (bf16)lo;
        }
    }
    if (PM == 0) row_pass<0>(F, arg_in(F.kp, I_N1G));
}

__device__ __forceinline__ void mid_phase(const Frame& F, int l) {
    LAS bf16* WL = (LAS bf16*)F.lds;
    LAS bf16* VT = (LAS bf16*)(F.lds + 34816);
    LAS float* ST = (LAS float*)(F.lds + 69632);
    LAS bf16* MX = (LAS bf16*)(F.lds + 70656);
    const int tid = F.tid, lane = F.lane, w = F.wave, fr = lane & 15, fq = lane >> 4; const bool f8 = l >= G2_F8_FROM;
    const bf16* XC = (const bf16*)(F.ws + WS_XC); const bf16* BB = (const bf16*)(F.ws + WS_BB); const bf16* U = (const bf16*)(F.ws + WS_U); const bf16* V = (const bf16*)(F.ws + WS_V);
    const f32x2* VST = (const f32x2*)(F.ws + WS_VSTAT); bf16* YAB = (bf16*)(F.ws + WS_YAB);
    const int per = (1024 + F.G - 1) / F.G; const int it0 = F.vcu * per, it1 = (it0 + per) < 1024 ? (it0 + per) : 1024;
    int gcur = -1;
    const int cc = (tid & 15) * 8;
#pragma unroll 1
    for (int it = it0; it < it1; ++it) {
        const int g = it >> 7, ch = it & 127, row0 = ch * CHUNK;
        f32x4 w0[2], w1[2], w2[2], lg0, lg1, lb0, lb1; float sbv[8];
        {
            const float* cw = arg_in(F.kp, I_CONVW) + (size_t)l * 3 * CW + g * 128 + cc;
#pragma unroll
            for (int q = 0; q < 2; ++q) { w0[q] = *(const f32x4*)(cw + 4 * q); w1[q] = *(const f32x4*)(cw + CW + 4 * q); w2[q] = *(const f32x4*)(cw + 2 * CW + 4 * q); }
        }
        u32x4 X0[4], X1[4], X2[4], BBv[4], Vv[4], UU[4]; f32x2 SP[16];
        {
            const u32x4 z = (u32x4){0u, 0u, 0u, 0u};
#pragma unroll
            for (int i = 0; i < 4; ++i) { const int t = (tid >> 4) + 32 * i, row = row0 + t, ts = row & (SEQ - 1); const size_t o = (size_t)row * CW + g * 128 + cc;
                X0[i] = *(const u32x4*)(XC + o); X1[i] = ts >= 1 ? *(const u32x4*)(XC + o - CW) : z; X2[i] = ts >= 2 ? *(const u32x4*)(XC + o - 2 * CW) : z; BBv[i] = *(const u32x4*)(BB + o); }
            if (tid < 128) {
#pragma unroll
                for (int i = 0; i < 16; ++i) SP[i] = VST[(size_t)(row0 + tid) * 16 + i]; }
#pragma unroll
            for (int i = 0; i < 4; ++i) Vv[i] = *(const u32x4*)(V + (size_t)(row0 + (tid >> 4) + 32 * i) * CW + g * 128 + cc);
#pragma unroll
            for (int i = 0; i < 4; ++i) UU[i] = *(const u32x4*)(U + (size_t)(row0 + (tid >> 4) + 32 * i) * CW + g * 128 + cc);
        }
        {
#pragma unroll
            for (int i = 0; i < 4; ++i) { const int t = (tid >> 4) + 32 * i, row = row0 + t;
                const unsigned A0[4] = {X0[i].x, X0[i].y, X0[i].z, X0[i].w}, A1[4] = {X1[i].x, X1[i].y, X1[i].z, X1[i].w}, A2[4] = {X2[i].x, X2[i].y, X2[i].z, X2[i].w}, Bq[4] = {BBv[i].x, BBv[i].y, BBv[i].z, BBv[i].w};
                float yl[4], yh[4];
#pragma unroll
                for (int p = 0; p < 4; ++p) { const int q = p >> 1, e = (p & 1) * 2;
                    yl[p] = bflo(Bq[p]) * (w0[q][e] * bflo(A2[p]) + w1[q][e] * bflo(A1[p]) + w2[q][e] * bflo(A0[p]));
                    yh[p] = bfhi(Bq[p]) * (w0[q][e + 1] * bfhi(A2[p]) + w1[q][e + 1] * bfhi(A1[p]) + w2[q][e + 1] * bfhi(A0[p])); }
                if (f8) {
#pragma unroll
                    for (int p = 0; p < 4; ++p) { yl[p] = __builtin_amdgcn_fmed3f(yl[p], -448.f, 448.f); yh[p] = __builtin_amdgcn_fmed3f(yh[p], -448.f, 448.f); }
                    *(u32x2*)((unsigned char*)YAB + (size_t)row * D + g * 128 + cc) = (u32x2){pk4_fp8(yl[0], yh[0], yl[1], yh[1]), pk4_fp8(yl[2], yh[2], yl[3], yh[3])}; }
                else *(u32x4*)(YAB + (size_t)row * D + g * 128 + cc) = (u32x4){cvt_pk_bf16(yl[0], yh[0]), cvt_pk_bf16(yl[1], yh[1]), cvt_pk_bf16(yl[2], yh[2]), cvt_pk_bf16(yl[3], yh[3])}; }
        }
        {
            const float* lg = arg_in(F.kp, I_LNVG) + l * CW + g * 128 + cc; const float* lb = arg_in(F.kp, I_LNVB) + l * CW + g * 128 + cc;
            lg0 = *(const f32x4*)lg; lg1 = *(const f32x4*)(lg + 4); lb0 = *(const f32x4*)lb; lb1 = *(const f32x4*)(lb + 4);
            const float* sb = arg_in(F.kp, I_SGUB) + (size_t)(l * SG + g) * CHUNK;
#pragma unroll
            for (int tt = 0; tt < 8; ++tt) sbv[tt] = sb[16 * tt + fr];
        }
        __syncthreads();
        if (g != gcur) {
            const float* Wg = arg_in(F.kp, I_SGUW) + (size_t)(l * SG + g) * CHUNK * CHUNK;
#pragma unroll
            for (int i = 0; i < 8; ++i) { const int idx4 = tid + 512 * i, t = idx4 >> 5, s4 = (idx4 & 31) * 4; const f32x4 wv = *(const f32x4*)(Wg + t * CHUNK + s4);
                u32x2 o; o.x = cvt_pk_bf16(s4 + 0 <= t ? wv[0] : 0.f, s4 + 1 <= t ? wv[1] : 0.f); o.y = cvt_pk_bf16(s4 + 2 <= t ? wv[2] : 0.f, s4 + 3 <= t ? wv[3] : 0.f);
                *(LAS u32x2*)(WL + t * 136 + s4) = o; }
            gcur = g;
        }
        if (tid < 128) { float s = 0.f, q = 0.f;
#pragma unroll
            for (int i = 0; i < 16; ++i) { s += SP[i].x; q += SP[i].y; }
            const float mu = s * (1.0f / CW), var = q * (1.0f / CW) - mu * mu; ST[tid * 2] = mu; ST[tid * 2 + 1] = 1.0f / sqrtf(fmaxf(var, 0.f) + EPS); }
        __syncthreads();
        {
#pragma unroll
            for (int i = 0; i < 4; ++i) { const int s = (tid >> 4) + 32 * i; const u32x4 v = Vv[i];
                const float mu = ST[s * 2], rs = ST[s * 2 + 1];
                const float x[8] = {bflo(v.x), bfhi(v.x), bflo(v.y), bfhi(v.y), bflo(v.z), bfhi(v.z), bflo(v.w), bfhi(v.w)};
                float y[8];
#pragma unroll
                for (int j = 0; j < 8; ++j) { const float lgj = j < 4 ? lg0[j & 3] : lg1[j & 3], lbj = j < 4 ? lb0[j & 3] : lb1[j & 3]; y[j] = (x[j] - mu) * rs * lgj + lbj; }
                *(LAS u32x4*)(VT + s * 136 + cc) = (u32x4){cvt_pk_bf16(y[0], y[1]), cvt_pk_bf16(y[2], y[3]), cvt_pk_bf16(y[4], y[5]), cvt_pk_bf16(y[6], y[7])}; }
        }
        __syncthreads();
        {
            typedef short s16x4 __attribute__((ext_vector_type(4)));
            bf16x8 a[4];
            const LAS bf16* tp = VT + (8 * fq + (fr >> 2)) * 136 + 16 * w + 4 * (fr & 3);
#pragma unroll
            for (int ks = 0; ks < 4; ++ks) { const s16x4 lo4 = __builtin_amdgcn_ds_read_tr16_b64_v4i16((LAS s16x4*)(tp + 32 * ks * 136)), hi4 = __builtin_amdgcn_ds_read_tr16_b64_v4i16((LAS s16x4*)(tp + (32 * ks + 4) * 136));
                a[ks] = __builtin_shufflevector(lo4, hi4, 0, 1, 2, 3, 4, 5, 6, 7); }
#pragma unroll
            for (int tt = 0; tt < 8; ++tt) { f32x4 d = (f32x4){0.f, 0.f, 0.f, 0.f};
#pragma unroll
                for (int ks = 0; ks < 4; ++ks) if (32 * ks <= 16 * tt + 15) { const bf16x8 b = *(const LAS bf16x8*)(WL + (16 * tt + fr) * 136 + 32 * ks + 8 * fq); d = __builtin_amdgcn_mfma_f32_16x16x32_bf16(a[ks], b, d, 0, 0, 0); }
                const int t = 16 * tt + fr; const float bias = sbv[tt];
                *(LAS u32x2*)(MX + t * 136 + 16 * w + 4 * fq) = (u32x2){cvt_pk_bf16(d[0] + bias, d[1] + bias), cvt_pk_bf16(d[2] + bias, d[3] + bias)}; }
        }
        __syncthreads();
        {
#pragma unroll
            for (int i = 0; i < 4; ++i) { const int t = (tid >> 4) + 32 * i; const u32x4 mx = *(const LAS u32x4*)(MX + t * 136 + cc), uu = UU[i];
                float y[8] = {bflo(uu.x) * bflo(mx.x), bfhi(uu.x) * bfhi(mx.x), bflo(uu.y) * bflo(mx.y), bfhi(uu.y) * bfhi(mx.y), bflo(uu.z) * bflo(mx.z), bfhi(uu.z) * bfhi(mx.z), bflo(uu.w) * bflo(mx.w), bfhi(uu.w) * bfhi(mx.w)};
                if (f8) {
#pragma unroll
                    for (int j = 0; j < 8; ++j) y[j] = __builtin_amdgcn_fmed3f(y[j], -448.f, 448.f);
                    *(u32x2*)((unsigned char*)YAB + (size_t)(row0 + t) * D + CW + g * 128 + cc) = (u32x2){pk4_fp8(y[0], y[1], y[2], y[3]), pk4_fp8(y[4], y[5], y[6], y[7])}; }
                else *(u32x4*)(YAB + (size_t)(row0 + t) * D + CW + g * 128 + cc) = (u32x4){cvt_pk_bf16(y[0], y[1]), cvt_pk_bf16(y[2], y[3]), cvt_pk_bf16(y[4], y[5]), cvt_pk_bf16(y[6], y[7])}; }
        }
    }
    __syncthreads();
}

__device__ __forceinline__ void r2_phase(const Frame& F, int l, bool dry = false) {
    const int tid = F.tid, lane = F.lane, fr = lane & 15, fq = lane >> 4, pr = F.wave >> 1, kh = F.wave & 1;
    const bf16* H = (const bf16*)(F.ws + (l == 0 ? WS_H : WS_H1)); const bf16* DL = (const bf16*)(F.ws + WS_DELTA); unsigned char* XU8 = F.ws + WS_XN;
    const bf16* RTH = (const bf16*)(F.ws + WS_RT) + (size_t)(l * 2 + 0) * 48 * D; const bf16* RTL = (const bf16*)(F.ws + WS_RT) + (size_t)(l * 2 + 1) * 48 * D;
    const float* gain = arg_in(F.kp, I_N2G) + (size_t)l * D;
    constexpr int HBB = 64 * 272, DBB = 64 * 272;
    LAS float* GAIN = (LAS float*)F.lds;
    LAS unsigned char* HB = F.lds + 8192;
    LAS unsigned char* DB = F.lds + 8192 + 2 * HBB;
    LAS float* LG = (LAS float*)(F.lds + 8192 + F.wave * 4096);
    unsigned* cnt = F.ctl + CW_CNT + (l + (dry ? 2 : 0)) * 32 * 64; unsigned* toklist = (unsigned*)(F.ws + WS_TOKLIST);
    *(LAS f32x4*)(GAIN + 4 * tid) = *(const f32x4*)(gain + 4 * tid);
    float rgb[4], reb[32];
#pragma unroll
    for (int i = 0; i < 4; ++i) rgb[i] = arg_in(F.kp, I_RGB)[l * NGRP + i];
#pragma unroll
    for (int i = 0; i < 32; ++i) reb[i] = arg_in(F.kp, I_REB)[l * NE + i];
    const bf16* bh = RTH + (size_t)fr * D + 8 * fq; const bf16* bl = RTL + (size_t)fr * D + 8 * fq;
#pragma unroll 1
    for (int tg = F.vcu; tg < NTOK / 64; tg += F.G) {
        const int rowb = tg * 64, row0 = rowb + pr * 16;
        f32x4 acc[3] = {(f32x4){0.f, 0.f, 0.f, 0.f}, (f32x4){0.f, 0.f, 0.f, 0.f}, (f32x4){0.f, 0.f, 0.f, 0.f}};
        float ss = 0.f;
        const bf16* hsrc = H + (size_t)(rowb + (tid >> 4)) * D + 8 * (tid & 15); const bf16* dsrc = DL + (size_t)(rowb + (tid >> 4)) * D + 8 * (tid & 15);
        const int ddst = (tid >> 4) * 272 + (tid & 15) * 16, hdst = ddst;
        u32x4 hr[2]; u32x4 dr[2];
#pragma unroll
        for (int i = 0; i < 2; ++i) { hr[i] = *(const u32x4*)(hsrc + (size_t)(32 * i) * D); dr[i] = *(const u32x4*)(dsrc + (size_t)(32 * i) * D); }
        __syncthreads();
#pragma unroll
        for (int i = 0; i < 2; ++i) { *(LAS u32x4*)(HB + hdst + i * 32 * 272) = hr[i]; *(LAS u32x4*)(DB + ddst + i * 32 * 272) = dr[i]; }
        __syncthreads();
        bf16x8 BHa[2][3], BLa[2][3], BHb[2][3], BLb[2][3];
#define R2_BLOAD(BH, BL, kc_) do { const int kg0_ = (kc_) * 128 + 64 * kh; \
            _Pragma("unroll") for (int j = 0; j < 2; ++j) _Pragma("unroll") for (int eb = 0; eb < 3; ++eb) { BH[j][eb] = *(const bf16x8*)(bh + (size_t)(16 * eb) * D + kg0_ + 32 * j); if (ROUTER_SPLIT) BL[j][eb] = *(const bf16x8*)(bl + (size_t)(16 * eb) * D + kg0_ + 32 * j); } } while (0)
#define R2_HLOAD(kc_) do { _Pragma("unroll") for (int i = 0; i < 2; ++i) { hr[i] = *(const u32x4*)(hsrc + (size_t)(32 * i) * D + (kc_) * 128); dr[i] = *(const u32x4*)(dsrc + (size_t)(32 * i) * D + (kc_) * 128); } } while (0)
#define R2_HPUT(buf_) do { _Pragma("unroll") for (int i = 0; i < 2; ++i) { *(LAS u32x4*)(HB + (buf_) * HBB + hdst + i * 32 * 272) = hr[i]; *(LAS u32x4*)(DB + (buf_) * DBB + ddst + i * 32 * 272) = dr[i]; } } while (0)
#define R2_COMPUTE(BH, BL, kc_, buf_) do { \
            const int kg0 = (kc_) * 128 + 64 * kh; u32x2 Q[2]; \
            _Pragma("unroll") for (int j = 0; j < 2; ++j) { \
                const int kl = 64 * kh + 32 * j + 8 * fq; \
                const LAS unsigned char* hp = HB + (buf_) * HBB + (pr * 16 + fr) * 272 + kl * 2; const LAS unsigned char* dp = DB + (buf_) * DBB + (pr * 16 + fr) * 272 + kl * 2; \
                const u32x4 hv = *(const LAS u32x4*)hp; const f32x4 H0 = unlo(hv), H1 = unhi(hv); const u32x4 dl = *(const LAS u32x4*)dp; \
                const f32x4 G0 = *(const LAS f32x4*)(GAIN + (kc_) * 128 + kl), G1 = *(const LAS f32x4*)(GAIN + (kc_) * 128 + kl + 4); \
                const f32x4 h0 = H0 + unlo(dl), h1 = H1 + unhi(dl); \
                ss += (h0[0] * h0[0] + h0[1] * h0[1]) + (h0[2] * h0[2] + h0[3] * h0[3]) + (h1[0] * h1[0] + h1[1] * h1[1]) + (h1[2] * h1[2] + h1[3] * h1[3]); \
                const f32x4 x0 = h0 * G0, x1 = h1 * G1; \
                u32x4 hi; hi.x = cvt_pk_bf16(x0[0], x0[1]); hi.y = cvt_pk_bf16(x0[2], x0[3]); hi.z = cvt_pk_bf16(x1[0], x1[1]); hi.w = cvt_pk_bf16(x1[2], x1[3]); \
                Q[j] = (u32x2){pk4_fp8(x0[0], x0[1], x0[2], x0[3]), pk4_fp8(x1[0], x1[1], x1[2], x1[3])}; \
                const bf16x8 Ah = __builtin_bit_cast(bf16x8, hi); \
                if (ROUTER_SPLIT) { u32x4 lo; lo.x = cvt_pk_bf16(x0[0] - bflo(hi.x), x0[1] - bfhi(hi.x)); lo.y = cvt_pk_bf16(x0[2] - bflo(hi.y), x0[3] - bfhi(hi.y)); \
                    lo.z = cvt_pk_bf16(x1[0] - bflo(hi.z), x1[1] - bfhi(hi.z)); lo.w = cvt_pk_bf16(x1[2] - bflo(hi.w), x1[3] - bfhi(hi.w)); const bf16x8 Al = __builtin_bit_cast(bf16x8, lo); \
                    _Pragma("unroll") for (int eb = 0; eb < 3; ++eb) { acc[eb] = __builtin_amdgcn_mfma_f32_16x16x32_bf16(Al, BH[j][eb], acc[eb], 0, 0, 0); acc[eb] = __builtin_amdgcn_mfma_f32_16x16x32_bf16(Ah, BL[j][eb], acc[eb], 0, 0, 0); } } \
                _Pragma("unroll") for (int eb = 0; eb < 3; ++eb) acc[eb] = __builtin_amdgcn_mfma_f32_16x16x32_bf16(Ah, BH[j][eb], acc[eb], 0, 0, 0); } \
            _Pragma("unroll") for (int j = 0; j < 2; ++j) *(u32x2*)(XU8 + (size_t)(row0 + fr) * D + kg0 + 32 * j + 8 * fq) = Q[j]; } while (0)
        R2_BLOAD(BHa, BLa, 0);
#pragma unroll 1
        for (int kc = 0; kc < 16; kc += 2) {
            R2_BLOAD(BHb, BLb, kc + 1);
            R2_HLOAD(kc + 1);
            asm volatile("" ::: "memory");
            R2_COMPUTE(BHa, BLa, kc, 0);
            R2_HPUT(1);
            __syncthreads();
            if (kc + 2 < 16) { R2_BLOAD(BHa, BLa, kc + 2); R2_HLOAD(kc + 2); }
            asm volatile("" ::: "memory");
            R2_COMPUTE(BHb, BLb, kc + 1, 1);
            if (kc + 2 < 16) R2_HPUT(0);
            __syncthreads();
        }
#undef R2_BLOAD
#undef R2_HLOAD
#undef R2_HPUT
#undef R2_COMPUTE
        if (tid < 32) F.MISC[640 + tid] = 0u;
        ss += __shfl_xor(ss, 16); ss += __shfl_xor(ss, 32);
#pragma unroll
        for (int eb = 0; eb < 3; ++eb)
#pragma unroll
            for (int j = 0; j < 4; ++j) LG[(4 * fq + j) * 48 + 16 * eb + fr] = acc[eb][j];
        if (fq == 0) LG[768 + fr] = ss;
        __syncthreads();
        const bool router = (kh == 0 && lane < 16);
        int row = 0, e1 = 0, e2 = 0; unsigned l1 = 0u, l2 = 0u; float rstd = 0.f, w1 = 0.f, w2 = 0.f;
        if (router) {
            row = row0 + lane; const LAS float* lg = LG + lane * 48; const LAS float* lg2 = lg + 1024;
            rstd = 1.0f / sqrtf((LG[768 + lane] + LG[1024 + 768 + lane]) * (1.0f / D) + EPS);
            float gl[4];
#pragma unroll
            for (int i = 0; i < 4; ++i) gl[i] = (lg[i] + lg2[i]) * rstd + rgb[i];
            int gi = 0; float gm = gl[0];
#pragma unroll
            for (int i = 1; i < 4; ++i) if (gl[i] > gm) { gm = gl[i]; gi = i; }
            float gs = 0.f;
#pragma unroll
            for (int i = 0; i < 4; ++i) gs += __expf(gl[i] - gm);
            const float gwt = 1.0f / gs;
            float el[8];
#pragma unroll
            for (int j = 0; j < 8; ++j) { const float b0 = gi == 0 ? reb[j] : (gi == 1 ? reb[8 + j] : (gi == 2 ? reb[16 + j] : reb[24 + j])); el[j] = (lg[4 + gi * 8 + j] + lg2[4 + gi * 8 + j]) * rstd + b0; }
            int i1 = 0; float m1 = el[0];
#pragma unroll
            for (int j = 1; j < 8; ++j) if (el[j] > m1) { m1 = el[j]; i1 = j; }
            int i2 = -1; float m2 = -3.0e38f;
#pragma unroll
            for (int j = 0; j < 8; ++j) if (j != i1 && el[j] > m2) { m2 = el[j]; i2 = j; }
            const float ex = __expf(m2 - m1); w1 = gwt / (1.0f + ex); w2 = gwt * ex / (1.0f + ex);
            e1 = gi * 8 + i1; e2 = gi * 8 + i2;
            l1 = __hip_atomic_fetch_add((LAS unsigned*)(F.lds + MISC_OFF) + 640 + e1, 1u, __ATOMIC_RELAXED, __HIP_MEMORY_SCOPE_WORKGROUP);
            l2 = __hip_atomic_fetch_add((LAS unsigned*)(F.lds + MISC_OFF) + 640 + e2, 1u, __ATOMIC_RELAXED, __HIP_MEMORY_SCOPE_WORKGROUP);
        }
        __syncthreads();
        if (tid < 32) { const unsigned c = F.MISC[640 + tid]; F.MISC[672 + tid] = c ? __hip_atomic_fetch_add(cnt + tid * 64, c, __ATOMIC_RELAXED, __HIP_MEMORY_SCOPE_AGENT) : 0u; }
        __syncthreads();
        if (router) {
            const unsigned r1 = F.MISC[672 + e1] + l1, r2 = F.MISC[672 + e2] + l2;
            *(u32x2*)(toklist + 2 * ((size_t)e1 * LISTCAP + r1)) = (u32x2){(unsigned)row, __float_as_uint(rstd)}; *(u32x2*)(toklist + 2 * ((size_t)e2 * LISTCAP + r2)) = (u32x2){(unsigned)row, __float_as_uint(rstd)};
            *(u32x4*)(F.ws + WS_TOKINFO + (size_t)row * 32) = (u32x4){(unsigned)e1, r1, (unsigned)e2, r2}; *(f32x2*)(F.ws + WS_TOKINFO + (size_t)row * 32 + 16) = (f32x2){w1, w2};
        }
        __syncthreads();
    }
}

__device__ __forceinline__ void moe_table(const Frame& F, int l) {
    const int tid = F.tid;
    __syncthreads();
    if (tid < 64) {
        const unsigned c = tid < 32 ? __hip_atomic_load(F.ctl + CW_CNT + (l * 32 + tid) * 64, __ATOMIC_RELAXED, __HIP_MEMORY_SCOPE_AGENT) : 0u;
        const int nb = (int)((c + 255u) >> 8); int incl = nb;
#pragma unroll
        for (int d = 1; d < 32; d <<= 1) { const int t = __shfl_up(incl, d); if (tid >= d) incl += t; }
        const int excl = incl - nb;
        if (tid < 32) { F.MISC[64 + tid] = c; F.MISC[16 + tid] = (unsigned)excl;
            for (int b = 0; b < nb; ++b) { F.MISC[320 + excl + b] = ((int)c - b * 256 > 128) ? 1u : 0u; F.MISC[480 + excl + b] = (unsigned)tid; } }
        if (tid == 31) { F.MISC[16 + 32] = (unsigned)incl; F.MISC[127] = (unsigned)((incl + 7) >> 3); }
    }
    __syncthreads();
    const int R = (int)F.MISC[48], rc = (int)F.MISC[127];
    if (tid < R) { const int full = (int)F.MISC[320 + tid]; const int lo = (tid / rc) * rc, hi = (lo + rc) < R ? (lo + rc) : R; int nfull = 0, before = 0;
        for (int r = lo; r < hi; ++r) { const int f = (int)F.MISC[320 + r]; nfull += f; before += (r < tid) ? f : 0; }
        F.MISC[128 + (full ? lo + before : lo + nfull + (tid - lo - before))] = (unsigned)tid; }
    __syncthreads();
}


__global__ void __launch_bounds__(NWAVES * 64, 2) mk_fwd(Args args) {
    __shared__ __attribute__((aligned(16))) unsigned char lds_raw[LDS_BYTES];
    Frame F;
    F.lds = (LAS unsigned char*)lds_raw; F.MISC = (volatile LAS unsigned*)(F.lds + MISC_OFF);
    F.tid = 0; F.lane = 0; F.wave = __builtin_amdgcn_readfirstlane((int)threadIdx.x >> 6);
    F.G = gridDim.x; { const int bx = blockIdx.x; F.vcu = (F.G % 8 == 0) ? (bx % 8) * (F.G / 8) + bx / 8 : bx; }
    F.kp = (kptr_t)__builtin_amdgcn_kernarg_segment_ptr(); F.ws = arg_ws(F.kp); F.out = arg_out(F.kp); F.ctl = (unsigned*)(F.ws + WS_CTL);
    for (int u = (int)threadIdx.x; u < (LDS_BYTES - MISC_OFF) / 4; u += NWAVES * 64) ((LAS unsigned*)(F.lds + MISC_OFF))[u] = 0u;
    __syncthreads();
    XcdBarrier bar = xcd_barrier_post(F.ctl + CW_BAR, F.MISC);
#define GRID_BAR() do { XcdBarrier b2_; b2_.x = (unsigned)launder_s((int)bar.x); b2_.st = F.MISC; b2_.bar = (unsigned*)(arg_ws(launder_k(F.kp)) + WS_CTL) + CW_BAR; xcd_barrier(b2_); } while (0)
    if (P0_PROBE) { { Frame P; phase_frame(F, P); p0_prologue<P0_PROBE>(P); } GRID_BAR(); }
    for (int rep = 0; rep < REP_P0; ++rep) { { Frame P; phase_frame(F, P); p0_prologue<0>(P); }
    GRID_BAR(); }

#pragma unroll 1
    for (int l = 0; l < DEPTH; ++l) {
        for (int rep = 0; rep < REP_G1; ++rep) {
#define G1_BF16_PART() do { Frame P; phase_frame(F, P); unsigned char* ws = P.ws; \
                pg8::DenseOrder S; S.init(NTOK, g1split, 2 * D, P.G, (int)blockIdx.x, ws + WS_XN, (const bf16*)(ws + WS_WIN) + (size_t)l * DIN * D); \
                EpiInProj E{ws, arg_in(P.kp, I_BGATE) + (size_t)l * 2 * D, 0}; \
                pg8::gemm_phase<EpiInProj, pg8::DenseOrder, GM_G1, true, KREP_G1>(P.lds, P.tid, D, S, E); } while (0)
#define G1_FP8_PART() do { Frame P; phase_frame(F, P); unsigned char* ws = P.ws; \
                pg8::DenseOrder S; S.init(NTOK, DIN - g1split, D, P.G, (int)blockIdx.x, ws + WS_XN8, ws + WS_WIN8 + (size_t)l * 6144 * D); \
                EpiInProj E{ws, arg_in(P.kp, I_BGATE) + (size_t)l * 2 * D, g1split >> 8}; \
                pg8::gemm_phase<EpiInProj, pg8::DenseOrder, GM_G1, true, 1, true>(P.lds, P.tid, D, S, E); } while (0)
            const bool fp8_first = ((blockIdx.x >> 3) & 1) != 0; const int g1split = l >= G1_F8_FROM ? G1_SPLIT : 5120;
#pragma unroll 1
            for (int step = 0; step < 2; ++step) { if ((step == 0) == fp8_first) G1_FP8_PART(); else G1_BF16_PART(); }
        GRID_BAR(); }
        for (int rep = 0; rep < REP_MID; ++rep) { { Frame P; phase_frame(F, P); mid_phase(P, l); }
        GRID_BAR(); }
        for (int rep = 0; rep < REP_G2; ++rep) {
            Frame P; phase_frame(F, P); unsigned char* ws = P.ws;
            const bool f8 = l >= G2_F8_FROM;
            pg8::DenseOrder S; S.init(NTOK, D, f8 ? D : 2 * D, P.G, (int)blockIdx.x, ws + WS_YAB, (const bf16*)(ws + WS_WBR) + (size_t)l * D * D);
            EpiBranch E{ws, l >= G3_F8_FROM};
            if (f8) pg8::gemm_phase<EpiBranch, pg8::DenseOrder, GM_G2, true, 1, true>(P.lds, P.tid, D, S, E);
            else pg8::gemm_phase<EpiBranch, pg8::DenseOrder, GM_G2, true>(P.lds, P.tid, D, S, E);
        GRID_BAR(); }
        for (int rep = 0; rep < (l == 0 ? REP_G3L0 : 1); ++rep) {
            Frame P; phase_frame(F, P); unsigned char* ws = P.ws;
            const bool f8 = l >= G3_F8_FROM;
            pg8::DenseOrder S; S.init(NTOK, D, f8 ? D : 2 * D, P.G, (int)blockIdx.x, ws + WS_XN, (const bf16*)(ws + WS_WOUT) + (size_t)l * D * D);
            EpiOut E{ws};
            if (f8) pg8::gemm_phase<EpiOut, pg8::DenseOrder, GM_G3, true, 1, true>(P.lds, P.tid, D, S, E);
            else pg8::gemm_phase<EpiOut, pg8::DenseOrder, GM_G3, true, KREP_G3>(P.lds, P.tid, D, S, E);
        GRID_BAR(); }
        for (int rep = 0; rep < REP_R2; ++rep) { { Frame P; phase_frame(F, P); r2_phase(P, l, rep < REP_R2 - 1); }
        GRID_BAR(); }
        { Frame P; phase_frame(F, P); moe_table(P, l); }
        for (int rep = 0; rep < REP_G4; ++rep) {
            Frame P; phase_frame(F, P); unsigned char* ws = P.ws;
            pg8::MoeOrder<true> S; S.rbs = (const LAS int*)(P.lds + MISC_OFF + 64); S.cnt = (const LAS int*)(P.lds + MISC_OFF + 256); S.ord = (const LAS int*)(P.lds + MISC_OFF + 512); S.npn = 4; S.vcu = P.vcu; S.G = P.G; S.pitch = D;
            S.A = (const char*)(ws + WS_XN); S.Bt = (const char*)(ws + WS_WGU + (size_t)l * NE * 1024 * D); S.bstride = (size_t)1024 * D; S.toklist = (const unsigned*)(ws + WS_TOKLIST);
            EpiGU E{ws};
            pg8::gemm_phase<EpiGU, pg8::MoeOrder<true>, GM_G4, true, 1, true, false>(P.lds, P.tid, D, S, E);
        GRID_BAR(); }
        for (int rep = 0; rep < REP_G5; ++rep) {
            Frame P; phase_frame(F, P); unsigned char* ws = P.ws;
            pg8::MoeOrder<false> S; S.rbs = (const LAS int*)(P.lds + MISC_OFF + 64); S.cnt = (const LAS int*)(P.lds + MISC_OFF + 256); S.ord = (const LAS int*)(P.lds + MISC_OFF + 512); S.npn = 8; S.vcu = P.vcu; S.G = P.G; S.pitch = DE;
            S.A = (const char*)(ws + WS_HMID); S.Bt = (const char*)(ws + WS_WD + (size_t)l * NE * D * DE); S.bstride = (size_t)D * DE; S.toklist = nullptr;
            EpiDown E{ws, l >= YS_F8_FROM};
            pg8::gemm_phase<EpiDown, pg8::MoeOrder<false>, GM_G5, true, KREP_G5, true, false>(P.lds, P.tid, DE, S, E);
        GRID_BAR(); }
        for (int rep = 0; rep < REP_R1; ++rep) {
        if (l == 0) { { Frame P; phase_frame(F, P); row_pass<1>(P, arg_in(P.kp, I_N1G) + D); } GRID_BAR(); }
        else { { Frame P; phase_frame(F, P); row_pass<2>(P, arg_in(P.kp, I_FG)); } if (rep < REP_R1 - 1) GRID_BAR(); } }
    }
}

extern "C" void kernel_launch(void* const* d_in, const int* in_sizes, int n_in, void* d_out, int out_size, void* d_ws, size_t ws_size, hipStream_t stream) {
    static int grid = 0;
    if (grid == 0) {
        if (n_in != 20 || in_sizes[0] != NTOK * D || out_size != NTOK * D || ws_size < WS_END) { fprintf(stderr, "kernel_launch: unexpected shapes / workspace (%d inputs, ws %zu)\n", n_in, ws_size); grid = -1; return; }
        int dev = 0, cus = 0;
        if (hipGetDevice(&dev) != hipSuccess || hipDeviceGetAttribute(&cus, hipDeviceAttributeMultiprocessorCount, dev) != hipSuccess) { grid = -1; return; }
        grid = cus;
    }
    if (grid < 0) return;
    (void)hipMemsetAsync((char*)d_ws + WS_CTL, 0, CTL_ZERO_BYTES, stream);
    Args a{};
    for (int i = 0; i < 20; ++i) a.in[i] = (const float*)d_in[i];
    a.out = (float*)d_out; a.ws = (unsigned char*)d_ws;
    hipLaunchKernelGGL(mk_fwd, dim3(grid), dim3(NWAVES * 64), 0, stream, a);
}
```

```cpp
#include <hip/hip_runtime.h>
#include <cstdio>
#include <cstdint>

#ifndef GEMM_MODE
#define GEMM_MODE 2
#endif
#ifndef GM_G1
#define GM_G1 GEMM_MODE
#endif
#ifndef GM_G2
#define GM_G2 GEMM_MODE
#endif
#ifndef GM_G3
#define GM_G3 GEMM_MODE
#endif
#ifndef GM_G4
#define GM_G4 GEMM_MODE
#endif
#ifndef GM_G5
#define GM_G5 GEMM_MODE
#endif

#ifndef KREP_G1
#define KREP_G1 1
#endif
#ifndef KREP_G3
#define KREP_G3 1
#endif
#ifndef KREP_G5
#define KREP_G5 1
#endif
#ifndef NT_STORE
#define YS_F8_FROM 1
#define G1_F8_FROM 1
#define G1_SPLIT 3072
#define G2_F8_FROM 1
#define G3_F8_FROM 1
#define NT_STORE 0
#endif
#ifndef P0_PROBE
#define P0_PROBE 0
#endif
#ifndef ROUTER_SPLIT
#define ROUTER_SPLIT 0
#endif
#ifndef REP_R1
#define REP_R1 1
#endif
#ifndef REP_R2
#define REP_R2 1
#endif
#ifndef REP_P0
#define REP_P0 1
#endif
#ifndef REP_G1
#define REP_G1 1
#endif
#ifndef REP_MID
#define REP_MID 1
#endif
#ifndef REP_G2
#define REP_G2 1
#endif
#ifndef REP_G3L0
#define REP_G3L0 1
#endif
#ifndef REP_G4
#define REP_G4 1
#endif
#ifndef REP_G5
#define REP_G5 1
#endif
#define LAS __attribute__((address_space(3)))
#define GAS __attribute__((address_space(1)))
typedef unsigned short bf16;
typedef short bf16x8 __attribute__((ext_vector_type(8)));
typedef float f32x4 __attribute__((ext_vector_type(4)));
typedef float f32x2 __attribute__((ext_vector_type(2)));
typedef unsigned u32x4 __attribute__((ext_vector_type(4)));
typedef unsigned u32x2 __attribute__((ext_vector_type(2)));

constexpr int NTOK = 16384, D = 2048, DEPTH = 2, SEQ = 4096;
constexpr int CW = 1024;
constexpr int DIN = 9216;
constexpr int NE = 32, DE = 512, EPG = 8, NGRP = 4;
constexpr int CHUNK = 128, SG = 8;
constexpr int PROWS = 40960;
constexpr int LISTCAP = 16384;
constexpr float EPS = 1e-6f;
constexpr int NWAVES = 8;

constexpr size_t MiB = 1u << 20;
constexpr size_t WS_CTL = 0, CTL_ZERO_BYTES = 64 * 1024;
constexpr size_t WS_TOKINFO = 1 * MiB;
constexpr size_t WS_RT = 2 * MiB;
constexpr size_t WS_TOKLIST = 3 * MiB;
constexpr size_t WS_VSTAT = 1008 * MiB;
constexpr size_t WS_WIN = 8 * MiB;
constexpr size_t WS_WBR = 80 * MiB;
constexpr size_t WS_WOUT = 96 * MiB;
constexpr size_t WS_WGU = 112 * MiB;
constexpr size_t WS_WIN8 = 240 * MiB;
constexpr size_t WS_XN8 = 944 * MiB;
constexpr size_t WS_WD = 368 * MiB;
constexpr size_t WS_H1 = 560 * MiB;
constexpr size_t WS_H = 496 * MiB;
constexpr size_t WS_XN = 624 * MiB;
constexpr size_t WS_XC = 688 * MiB, WS_BB = 720 * MiB, WS_U = 752 * MiB, WS_V = 784 * MiB, WS_GR = 816 * MiB, WS_GB = 880 * MiB;
constexpr size_t WS_YSLOT = 688 * MiB;
constexpr size_t WS_YAB = 944 * MiB;
constexpr size_t WS_HMID = 944 * MiB;
constexpr size_t WS_DELTA = 880 * MiB;
constexpr size_t WS_END = 1010 * MiB;
constexpr int CW_TMO = 0;
constexpr int CW_BAR = 4096;
constexpr int CW_CNT = 8192;

constexpr int RING_BYTES = 131072;
constexpr int P0_SCR = 64 * 65 * 4;
constexpr int MISC_OFF = 8 * P0_SCR + 2048;
constexpr int LDS_BYTES = 147456;

#define LDS_WAIT() asm volatile("s_waitcnt lgkmcnt(0)" ::: "memory")
#define VM_WAIT() asm volatile("s_waitcnt vmcnt(0)" ::: "memory")

__device__ __forceinline__ unsigned cvt_pk_bf16(float lo, float hi) { unsigned r; asm volatile("v_cvt_pk_bf16_f32 %0, %1, %2" : "=v"(r) : "v"(lo), "v"(hi)); return r; }
__device__ __forceinline__ unsigned pk4_fp8(float a, float b, float c, float d) { int w = 0; w = __builtin_amdgcn_cvt_pk_fp8_f32(a, b, w, false); w = __builtin_amdgcn_cvt_pk_fp8_f32(c, d, w, true); return (unsigned)w; }
__device__ __forceinline__ float bflo(unsigned w) { return __uint_as_float(w << 16); }
__device__ __forceinline__ float bfhi(unsigned w) { return __uint_as_float(w & 0xffff0000u); }
__device__ __forceinline__ float fast_sigmoid(float x) { return __builtin_amdgcn_rcpf(1.0f + __builtin_amdgcn_exp2f(-1.44269504f * x)); }
__device__ __forceinline__ float gelu_tanh(float x) { const float y = 0.7978845608f * (x + 0.044715f * x * x * x); return x * fast_sigmoid(2.0f * y); }
__device__ __forceinline__ f32x4 gelu_tanh4(const f32x4 x) {
    const float C1 = -2.0f * 0.7978845608f * 1.44269504f, C3 = C1 * 0.044715f;
    const f32x4 z = x * ((x * x) * C3 + C1); f32x4 t;
#pragma unroll
    for (int j = 0; j < 4; ++j) t[j] = __builtin_amdgcn_exp2f(z[j]);
    t = t + 1.0f;
#pragma unroll
    for (int j = 0; j < 4; ++j) t[j] = __builtin_amdgcn_rcpf(t[j]);
    return x * t;
}
__device__ __forceinline__ float wave_sum(float v) {
    int x = __float_as_int(v);
    v += __int_as_float(__builtin_amdgcn_update_dpp(0, x, 0xB1, 0xF, 0xF, true));  x = __float_as_int(v);
    v += __int_as_float(__builtin_amdgcn_update_dpp(0, x, 0x4E, 0xF, 0xF, true));  x = __float_as_int(v);
    v += __int_as_float(__builtin_amdgcn_update_dpp(0, x, 0x141, 0xF, 0xF, true)); x = __float_as_int(v);
    v += __int_as_float(__builtin_amdgcn_update_dpp(0, x, 0x140, 0xF, 0xF, true)); x = __float_as_int(v);
    return (__int_as_float(__builtin_amdgcn_readlane(x, 0)) + __int_as_float(__builtin_amdgcn_readlane(x, 16))) + (__int_as_float(__builtin_amdgcn_readlane(x, 32)) + __int_as_float(__builtin_amdgcn_readlane(x, 48)));
}

#define XB_TMO      128
#define XB_XCNT(j)  (256  + 64 * (j))
#define XB_XSUB(j)  (1280 + 64 * (j))
#define XB_XGEN(j)  (2304 + 64 * (j))
#define XB_TOP      3328
#define XB_TOPGEN   3392
#define XCD_BAR_WORDS 3456
#define XB_SPIN_CAP (1u << 18)
__device__ __forceinline__ unsigned xb_ld(unsigned* p)              { return __hip_atomic_load(p, __ATOMIC_RELAXED, __HIP_MEMORY_SCOPE_AGENT); }
__device__ __forceinline__ unsigned xb_add(unsigned* p, unsigned v) { return __hip_atomic_fetch_add(p, v, __ATOMIC_RELAXED, __HIP_MEMORY_SCOPE_AGENT); }
__device__ __forceinline__ unsigned xb_xcc_id() { return (unsigned)__builtin_amdgcn_s_getreg((3 << 11) | 20) & 0xFu; }
#define XB_SPIN(cond, bar) do { unsigned _sp = 0; while (cond) { __builtin_amdgcn_s_sleep(1); \
    if ((++_sp & 255u) == 0u) { if (xb_ld(&(bar)[XB_TMO])) break; if (_sp > XB_SPIN_CAP) { atomicAdd(&(bar)[XB_TMO], 1u); break; } } } } while (0)
struct XcdBarrier { unsigned* bar; unsigned x; volatile LAS unsigned* st; };
__device__ __forceinline__ XcdBarrier xcd_barrier_post(unsigned* bar, volatile LAS unsigned* st) {
    XcdBarrier b; b.bar = bar; b.x = xb_xcc_id(); b.st = st;
    if (threadIdx.x == 0) (void)xb_add(&bar[XB_XCNT(b.x)], 1u);
    return b;
}
__device__ __forceinline__ void xcd_barrier_complete(unsigned* bar, unsigned x, unsigned& nloc, unsigned& nx) {
    const unsigned G = gridDim.x * gridDim.y * gridDim.z;
    unsigned sum, cnt, mine, sp = 0u;
    for (;;) {
        sum = 0u; cnt = 0u; mine = 0u;
#pragma unroll
        for (unsigned j = 0; j < 16; ++j) { const unsigned c = xb_ld(&bar[XB_XCNT(j)]); sum += c; cnt += (c > 0u) ? 1u : 0u; mine = (j == x) ? c : mine; }
        if (sum == G) break;
        __builtin_amdgcn_s_sleep(1);
        if ((++sp & 255u) == 0u) { if (xb_ld(&bar[XB_TMO])) break; if (sp > XB_SPIN_CAP) { atomicAdd(&bar[XB_TMO], 1u); break; } }
    }
    nloc = mine > 0u ? mine : 1u; nx = cnt > 0u ? cnt : 1u;
}
__device__ __forceinline__ void xcd_barrier(const XcdBarrier& b) {
    asm volatile("s_waitcnt vmcnt(0)" ::: "memory");
    __syncthreads();
    if (threadIdx.x == 0) {
        unsigned* bar = b.bar;
        __builtin_amdgcn_s_waitcnt(0);
        unsigned nloc = b.st[0], nx = b.st[1];
        if (nloc == 0u) { xcd_barrier_complete(bar, b.x, nloc, nx); b.st[0] = nloc; b.st[1] = nx; }
        const unsigned old = xb_add(&bar[XB_XSUB(b.x)], 1u);
        const unsigned gen = old / nloc;
        if (old + 1u == (gen + 1u) * nloc) {
            __builtin_amdgcn_fence(__ATOMIC_RELEASE, "agent");
            asm volatile("s_waitcnt vmcnt(0)" ::: "memory");
            const unsigned og = xb_add(&bar[XB_TOP], 1u);
            const unsigned tg = og / nx;
            if (og + 1u == (tg + 1u) * nx) xb_add(&bar[XB_TOPGEN], 1u);
            else XB_SPIN(xb_ld(&bar[XB_TOPGEN]) == tg, bar);
            __builtin_amdgcn_fence(__ATOMIC_ACQUIRE, "agent");
            xb_add(&bar[XB_XGEN(b.x)], 1u);
            asm volatile("s_waitcnt vmcnt(0)" ::: "memory");
        } else {
            XB_SPIN(xb_ld(&bar[XB_XGEN(b.x)]) == gen, bar);
            __builtin_amdgcn_fence(__ATOMIC_ACQUIRE, "agent");
            asm volatile("s_waitcnt vmcnt(0)" ::: "memory");
        }
    }
    __syncthreads();
}

__device__ __forceinline__ int fresh_lane() { int ln; asm volatile("v_mbcnt_lo_u32_b32 %0, -1, 0\n\tv_mbcnt_hi_u32_b32 %0, -1, %0" : "=&v"(ln)); return ln; }
namespace pg8 {
constexpr int BM = 256, BK = 64, HALF = 128, HTB = HALF * BK * 2, STAGE_BYTES = 8 * HTB, NXCD = 8, WGM = 8;
__host__ __device__ __forceinline__ int lds_byte(int r, int c) { const int st = (r >> 4) * 2 + (c >> 5), rr = r & 15, cc = c & 31, ob = rr * 64 + cc * 2; return st * 1024 + (ob ^ (((ob >> 9) & 1) << 5)); }
__host__ __device__ __forceinline__ void stage_rc(int b, int& R, int& C) { const int st = b / 1024, sb = b % 1024, swz = sb ^ (((sb >> 9) & 1) << 5); R = (st >> 1) * 16 + swz / 64; C = (st & 1) * 32 + (swz % 64) / 2; }
__host__ __device__ __forceinline__ int perm32(int rho) { const int n = rho >> 4, i = rho & 15; return 8 * (i >> 2) + 4 * n + (i & 3); }

struct Unit { int pm, pn, e, rbl, nvalid; };

struct DenseOrder {
    static constexpr bool AOFF_LOADS = false;
    int nM, nN, nwg, G, c, pitch; const char* A; const char* Bt;
    __device__ void init(int M, int N, int pitch_, int G_, int c_, const void* A_, const void* Bt_) { nM = M / BM; nN = N / BM; nwg = nM * nN; G = G_; c = c_; pitch = pitch_; A = (const char*)A_; Bt = (const char*)Bt_; }
    __device__ __forceinline__ bool next(int i, Unit& u) const {
        const long L = (long)i * G + c; if (L >= nwg) return false;
        int wgid = (int)L; { const int q = nwg / NXCD, r = nwg % NXCD, xcd = wgid % NXCD, off = wgid / NXCD; wgid = (xcd < r ? xcd * (q + 1) : r * (q + 1) + (xcd - r) * q) + off; }
        const int nig = WGM * nN, gid = wgid / nig, fm = gid * WGM, gsz = (nM - fm) < WGM ? (nM - fm) : WGM;
        u.pm = fm + ((wgid % nig) % gsz); u.pn = (wgid % nig) / gsz; u.e = 0; u.rbl = 0; u.nvalid = 256; return true;
    }
    __device__ __forceinline__ const char* a_base(const Unit& u) const { return A + (size_t)u.pm * BM * pitch; }
    __device__ __forceinline__ const char* b_base(const Unit& u) const { return Bt + (size_t)u.pn * BM * pitch; }
    __device__ __forceinline__ unsigned a_row_off(const Unit&, int r) const { return (unsigned)(r * pitch); }
};

template <bool GATHER> struct MoeOrder {
    static constexpr bool AOFF_LOADS = GATHER;
    const LAS int* rbs; const LAS int* cnt; const LAS int* ord; int npn, vcu, G, pitch;
    const char* A; const char* Bt; size_t bstride; const unsigned* toklist;
    __device__ __forceinline__ bool next(int i, Unit& u) const {
        const int R = rbs[32], rc = ord[-1], gp = G >> 3, x = vcu / gp, j = i * gp + (vcu % gp);
        const int rbi = j / npn, lo = x * rc, nloc = (lo + rc < R ? lo + rc : R) - lo;
        if (rbi >= nloc) return false;
        const int L = j, rb = ord[lo + rbi]; const int e = ord[352 + rb];
        u.pm = rb; u.pn = L - rbi * npn; u.e = e; u.rbl = rb - rbs[e];
        const int left = cnt[e] - u.rbl * 256; u.nvalid = left < 256 ? left : 256; return true;
    }
    __device__ __forceinline__ const char* a_base(const Unit& u) const { return GATHER ? A : A + (size_t)u.pm * BM * pitch; }
    __device__ __forceinline__ const char* b_base(const Unit& u) const { return Bt + (size_t)u.e * bstride + (size_t)u.pn * BM * pitch; }
    __device__ __forceinline__ unsigned a_row_off(const Unit& u, int r) const {
        if (!GATHER) return (unsigned)(r * pitch);
        const int rc = r < u.nvalid ? r : u.nvalid - 1;
        const unsigned tok = toklist[2 * (unsigned)(u.e * LISTCAP + u.rbl * 256 + rc)];
        return tok * (unsigned)pitch;
    }
};

typedef int i32x4 __attribute__((ext_vector_type(4)));
typedef int i32x8 __attribute__((ext_vector_type(8)));
__device__ __forceinline__ i32x8 cat16(const bf16x8 a, const bf16x8 b) { return __builtin_shufflevector(__builtin_bit_cast(i32x4, a), __builtin_bit_cast(i32x4, b), 0, 1, 2, 3, 4, 5, 6, 7); }
template <class Epi, class Sched, int MODE, bool ALIGN_EPI, int KREP = 1, bool F8 = false, bool LIGHT = false>
__device__ __forceinline__ void gemm_phase(LAS unsigned char* lds, const int tid, const int K, const Sched& S, const Epi& E) {
    const int wid = __builtin_amdgcn_readfirstlane(tid >> 6), lane = tid & 63, wr = wid >> 2, wc = wid & 3, fr = lane & 15, fq = lane >> 4;
    if constexpr (MODE == 9) return;
    const int nt = F8 ? K / 128 : K / BK, pitch = F8 ? K : 2 * K;
    static_assert(!(F8 && MODE == 0), "direct mode is bf16 only");
    f32x4 acc[2][2][4][2];
#define PG8_ZERO_ACC() do { _Pragma("unroll") for (int a = 0; a < 2; ++a) _Pragma("unroll") for (int b = 0; b < 2; ++b) _Pragma("unroll") for (int m = 0; m < 4; ++m) _Pragma("unroll") for (int n = 0; n < 2; ++n) acc[a][b][m][n] = (f32x4){0.f, 0.f, 0.f, 0.f}; } while (0)
    if constexpr (MODE == 0) {
        Unit cur;
#pragma unroll 1
        for (int ui = 0; S.next(ui, cur); ++ui) {
            PG8_ZERO_ACC();
            const char* Ab = S.a_base(cur); const char* Bb = S.b_base(cur);
            unsigned ao[2][4], bo[2][2];
#pragma unroll
            for (int ai = 0; ai < 2; ++ai)
#pragma unroll
                for (int m = 0; m < 4; ++m) ao[ai][m] = S.a_row_off(cur, ai * HALF + wr * 64 + m * 16 + fr) + (unsigned)(fq * 16);
#pragma unroll
            for (int bj = 0; bj < 2; ++bj)
#pragma unroll
                for (int n = 0; n < 2; ++n) { const int rho = n * 16 + fr, brow = bj * HALF + wc * 32 + (Epi::PERM ? perm32(rho) : rho); bo[bj][n] = (unsigned)(brow * pitch + fq * 16); }
#pragma unroll 1
            for (int t2 = 0; t2 < 2 * nt; ++t2) {
                if constexpr (Epi::MID) { if (t2 == nt) { const int ln_ = fresh_lane(); E.mid(acc, cur, wr, wc, ln_ & 15, ln_ >> 4); } }
                {
                    bf16x8 Af[2][4], Bf[2][2];
                    const unsigned ko = (unsigned)(t2 * 64);
#pragma unroll
                    for (int ai = 0; ai < 2; ++ai)
#pragma unroll
                        for (int m = 0; m < 4; ++m) Af[ai][m] = *(const bf16x8*)(Ab + ao[ai][m] + ko);
#pragma unroll
                    for (int bj = 0; bj < 2; ++bj)
#pragma unroll
                        for (int n = 0; n < 2; ++n) Bf[bj][n] = *(const bf16x8*)(Bb + bo[bj][n] + ko);
#pragma unroll
                    for (int ai = 0; ai < 2; ++ai)
#pragma unroll
                        for (int bj = 0; bj < 2; ++bj)
#pragma unroll
                            for (int m = 0; m < 4; ++m)
#pragma unroll
                                for (int n = 0; n < 2; ++n) acc[ai][bj][m][n] = __builtin_amdgcn_mfma_f32_16x16x32_bf16(Bf[bj][n], Af[ai][m], acc[ai][bj][m][n], 0, 0, 0);
                }
            }
            { const int ln_ = fresh_lane(); E(acc, cur, wr, wc, ln_ & 15, ln_ >> 4); }
        }
    } else {
        int Rr[2], Cc[2]; unsigned voffB[2];
#pragma unroll
        for (int i = 0; i < 2; ++i) { stage_rc(tid * 16 + i * 8192, Rr[i], Cc[i]); const int Rb = Epi::PERM ? ((Rr[i] & ~31) + perm32(Rr[i] & 31)) : Rr[i]; voffB[i] = (unsigned)(Rb * pitch + Cc[i] * 2); }
        const size_t kstep = (size_t)(BK * 2);
        const size_t hstep = (size_t)HALF * pitch;
        const unsigned ldsw = (unsigned)wid * 1024u;
        const int aoff = lds_byte(wr * 64 + fr, fq * 8), boff = lds_byte(wc * 32 + fr, fq * 8);
#define PG8_SA(b, h) (((b) * 2 + (h)) * HTB)
#define PG8_SB(b, h) ((4 + (b) * 2 + (h)) * HTB)
#define PG8_STAGE(bufoff, gbase, voff) do { _Pragma("unroll") for (int _i = 0; _i < 2; ++_i) \
        __builtin_amdgcn_global_load_lds((const unsigned*)((const char*)(gbase) + (voff)[_i]), (LAS unsigned*)(lds + (bufoff) + ldsw + _i * 8192), 16, 0, 0); } while (0)
#define PG8_LDA(dst, b, h) do { if constexpr (F8) { _Pragma("unroll") for (int m = 0; m < 4; ++m) { dst##8[m].lo = *(const LAS i32x4*)(lds + PG8_SA(b, h) + aoff + m * 2048); dst##8[m].hi = *(const LAS i32x4*)(lds + PG8_SA(b, h) + aoff + m * 2048 + 1024); } } \
        else { _Pragma("unroll") for (int m = 0; m < 4; ++m) _Pragma("unroll") for (int k = 0; k < 2; ++k) dst[m][k] = *(const LAS bf16x8*)(lds + PG8_SA(b, h) + aoff + m * 2048 + k * 1024); } } while (0)
#define PG8_LDB(dst, b, h) do { if constexpr (F8) { _Pragma("unroll") for (int n = 0; n < 2; ++n) { dst##8[n].lo = *(const LAS i32x4*)(lds + PG8_SB(b, h) + boff + n * 2048); dst##8[n].hi = *(const LAS i32x4*)(lds + PG8_SB(b, h) + boff + n * 2048 + 1024); } } \
        else { _Pragma("unroll") for (int n = 0; n < 2; ++n) _Pragma("unroll") for (int k = 0; k < 2; ++k) dst[n][k] = *(const LAS bf16x8*)(lds + PG8_SB(b, h) + boff + n * 2048 + k * 1024); } } while (0)
#define PG8_MMA(ai, bj, At, Bt) do { __builtin_amdgcn_s_setprio(1); \
        if constexpr (F8) { _Pragma("unroll") for (int m = 0; m < 4; ++m) _Pragma("unroll") for (int n = 0; n < 2; ++n) \
            asm volatile("s_nop 1\n\tv_mfma_scale_f32_16x16x128_f8f6f4 %0, %1, %2, %0, %3, %4 op_sel_hi:[0,0,0]" : "+v"(acc[ai][bj][m][n]) : "v"(Bt##8[n]), "v"(At##8[m]), "v"(sc_w), "v"(sc_x)); } \
        else { _Pragma("unroll") for (int m = 0; m < 4; ++m) _Pragma("unroll") for (int n = 0; n < 2; ++n) _Pragma("unroll") for (int k = 0; k < 2; ++k) \
            acc[ai][bj][m][n] = __builtin_amdgcn_mfma_f32_16x16x32_bf16(Bt[n][k], At[m][k], acc[ai][bj][m][n], 0, 0, 0); } \
        __builtin_amdgcn_s_setprio(0); } while (0)
#define PG8_WAIT_V(n) asm volatile("s_waitcnt vmcnt(" #n ")" ::: "memory")
#define PG8_WAIT_L(n) asm volatile("s_waitcnt lgkmcnt(" #n ")" ::: "memory")
#define PG8_BAR __builtin_amdgcn_s_barrier()
#define PG8_SCHED __builtin_amdgcn_sched_barrier(0)
#define PG8_AOFFS(dst, u) do { _Pragma("unroll") for (int _h = 0; _h < 2; ++_h) _Pragma("unroll") for (int _i = 0; _i < 2; ++_i) dst[_h][_i] = S.a_row_off(u, _h * HALF + Rr[_i]) + (unsigned)(Cc[_i] * 2); } while (0)
        constexpr bool SP2 = (MODE == 2);
        const int sc_w = 122, sc_x = 127;
        Unit cur, nxt; int ui = 0;
        if (!S.next(0, cur)) return;
        PG8_ZERO_ACC();
        bf16x8 At[4][2], B0[2][2], B1[2][2]; i32x8 At8[4], B08[2], B18[2];
        const char* cA = S.a_base(cur); const char* cB = S.b_base(cur);
        unsigned cO[2][2], nO[2][2];
        PG8_AOFFS(cO, cur);
#pragma unroll
        for (int _h = 0; _h < 2; ++_h)
#pragma unroll
            for (int _i = 0; _i < 2; ++_i) nO[_h][_i] = cO[_h][_i];
        if constexpr (SP2) {
            PG8_STAGE(PG8_SB(0, 0), cB, voffB); PG8_STAGE(PG8_SB(0, 1), cB + hstep, voffB); PG8_STAGE(PG8_SA(0, 0), cA, cO[0]); PG8_STAGE(PG8_SA(0, 1), cA, cO[1]);
            if (wr == 1) PG8_BAR;
            PG8_WAIT_V(2); PG8_BAR;
            PG8_STAGE(PG8_SB(1, 0), cB + kstep, voffB); PG8_STAGE(PG8_SA(1, 0), cA + kstep, cO[0]); PG8_STAGE(PG8_SB(1, 1), cB + hstep + kstep, voffB);
            PG8_WAIT_V(6); PG8_BAR;
        } else {
            PG8_STAGE(PG8_SB(0, 0), cB, voffB); PG8_STAGE(PG8_SA(0, 0), cA, cO[0]); PG8_STAGE(PG8_SB(0, 1), cB + hstep, voffB); PG8_STAGE(PG8_SA(0, 1), cA, cO[1]);
            if (wr == 1) PG8_BAR;
            PG8_WAIT_V(4); PG8_BAR;
            PG8_STAGE(PG8_SB(1, 0), cB + kstep, voffB); PG8_STAGE(PG8_SA(1, 0), cA + kstep, cO[0]); PG8_STAGE(PG8_SB(1, 1), cB + hstep + kstep, voffB);
            PG8_WAIT_V(6); PG8_BAR;
        }
        for (;;) {
            const bool has_next = S.next(ui + 1, nxt);
            const bool lightu = LIGHT && cur.nvalid <= 128;
            const char* nA = has_next ? S.a_base(nxt) : cA; const char* nB = has_next ? S.b_base(nxt) : cB;
            if constexpr (!Sched::AOFF_LOADS) { if (has_next) PG8_AOFFS(nO, nxt); }
#pragma unroll 1
            for (int rep = 0; rep < KREP; ++rep)
#pragma unroll 1
            for (int t = 0; t < nt; t += 2) {
                const bool last = (t == nt - 2), lastrep = (rep == KREP - 1), sw = last && lastrep && has_next;
                if constexpr (Epi::MID) { if (t == nt / 2) { if constexpr (F8) asm volatile("s_nop 15\n\ts_nop 3" ::: "memory"); const int ln_ = fresh_lane(); E.mid(acc, cur, wr, wc, ln_ & 15, ln_ >> 4); } }
                if constexpr (Sched::AOFF_LOADS) if (t == 0 && rep == 0 && has_next) PG8_AOFFS(nO, nxt);
                const char* a1 = cA + (size_t)(t + 1) * kstep;
                const char* a2 = last ? (lastrep ? nA : cA) : cA + (size_t)(t + 2) * kstep; const char* b2 = last ? (lastrep ? nB : cB) : cB + (size_t)(t + 2) * kstep;
                const char* a3 = a2 + kstep; const char* b3 = b2 + kstep;
                unsigned o2[2][2];
#pragma unroll
                for (int _h = 0; _h < 2; ++_h)
#pragma unroll
                    for (int _i = 0; _i < 2; ++_i) o2[_h][_i] = sw ? nO[_h][_i] : cO[_h][_i];
                if constexpr (SP2) {
                    PG8_LDB(B0, 0, 0); PG8_LDB(B1, 0, 1); PG8_SCHED; PG8_LDA(At, 0, 0); PG8_STAGE(PG8_SA(1, 1), a1, cO[1]);
                    PG8_WAIT_V(8); PG8_WAIT_L(0); PG8_BAR; PG8_MMA(0, 0, At, B0); PG8_MMA(0, 1, At, B1); PG8_BAR; PG8_SCHED;
                    if (!lightu) PG8_LDA(At, 0, 1); PG8_STAGE(PG8_SB(0, 0), b2, voffB); PG8_STAGE(PG8_SB(0, 1), b2 + hstep, voffB); PG8_STAGE(PG8_SA(0, 0), a2, o2[0]);
                    PG8_WAIT_V(8); PG8_WAIT_L(0); PG8_BAR; if (!lightu) { PG8_MMA(1, 0, At, B0); PG8_MMA(1, 1, At, B1); } PG8_BAR; PG8_SCHED;
                    PG8_LDB(B0, 1, 0); PG8_LDB(B1, 1, 1); PG8_SCHED; PG8_LDA(At, 1, 0); PG8_STAGE(PG8_SA(0, 1), a2, o2[1]);
                    PG8_WAIT_V(8); PG8_WAIT_L(0); PG8_BAR; PG8_MMA(0, 0, At, B0); PG8_MMA(0, 1, At, B1); PG8_BAR; PG8_SCHED;
                    if (!lightu) PG8_LDA(At, 1, 1); PG8_STAGE(PG8_SB(1, 0), b3, voffB); PG8_STAGE(PG8_SB(1, 1), b3 + hstep, voffB); PG8_STAGE(PG8_SA(1, 0), a3, o2[0]);
                    PG8_WAIT_V(8); PG8_WAIT_L(0); PG8_BAR; if (!lightu) { PG8_MMA(1, 0, At, B0); PG8_MMA(1, 1, At, B1); } PG8_BAR; PG8_SCHED;
                } else {
                    PG8_LDB(B0, 0, 0); PG8_SCHED; PG8_LDA(At, 0, 0); PG8_STAGE(PG8_SA(1, 1), a1, cO[1]);
                    PG8_WAIT_L(8); PG8_BAR; PG8_WAIT_L(0); PG8_MMA(0, 0, At, B0); PG8_BAR; PG8_SCHED;
                    PG8_LDB(B1, 0, 1); PG8_STAGE(PG8_SB(0, 0), b2, voffB);
                    PG8_BAR; PG8_WAIT_L(0); PG8_MMA(0, 1, At, B1); PG8_BAR;
                    PG8_LDA(At, 0, 1); PG8_STAGE(PG8_SA(0, 0), a2, o2[0]);
                    PG8_BAR; PG8_WAIT_L(0); PG8_MMA(1, 0, At, B0); PG8_BAR; PG8_SCHED;
                    PG8_STAGE(PG8_SB(0, 1), b2 + hstep, voffB);
                    PG8_WAIT_V(6); PG8_BAR; PG8_MMA(1, 1, At, B1); PG8_BAR;
                    PG8_LDB(B0, 1, 0); PG8_SCHED; PG8_LDA(At, 1, 0); PG8_STAGE(PG8_SA(0, 1), a2, o2[1]);
                    PG8_WAIT_L(8); PG8_BAR; PG8_WAIT_L(0); PG8_MMA(0, 0, At, B0); PG8_BAR; PG8_SCHED;
                    PG8_LDB(B1, 1, 1); PG8_STAGE(PG8_SB(1, 0), b3, voffB);
                    PG8_BAR; PG8_WAIT_L(0); PG8_MMA(0, 1, At, B1); PG8_BAR;
                    PG8_LDA(At, 1, 1); PG8_STAGE(PG8_SA(1, 0), a3, o2[0]);
                    PG8_BAR; PG8_WAIT_L(0); PG8_MMA(1, 0, At, B0); PG8_BAR; PG8_SCHED;
                    PG8_STAGE(PG8_SB(1, 1), b3 + hstep, voffB);
                    PG8_WAIT_V(6); PG8_BAR; PG8_MMA(1, 1, At, B1); PG8_BAR;
                }
            }
            if constexpr (ALIGN_EPI) { if (wr == 0) PG8_BAR; }
            if constexpr (F8) asm volatile("s_nop 15\n\ts_nop 3" ::: "memory");
            if constexpr (KREP > 1) { _Pragma("unroll") for (int a = 0; a < 2; ++a) _Pragma("unroll") for (int b = 0; b < 2; ++b) _Pragma("unroll") for (int m = 0; m < 4; ++m) _Pragma("unroll") for (int n = 0; n < 2; ++n) acc[a][b][m][n] *= (1.0f / KREP); }
            { const int ln_ = fresh_lane(); E(acc, cur, wr, wc, ln_ & 15, ln_ >> 4); }
            if (!has_next) break;
            PG8_ZERO_ACC();
            cur = nxt; cA = nA; cB = nB; ++ui;
#pragma unroll
            for (int _h = 0; _h < 2; ++_h)
#pragma unroll
                for (int _i = 0; _i < 2; ++_i) cO[_h][_i] = nO[_h][_i];
            if constexpr (ALIGN_EPI) { if (wr == 1) PG8_BAR; }
        }
        PG8_WAIT_V(0);
        if constexpr (!ALIGN_EPI) { if (wr == 0) PG8_BAR; }
        PG8_BAR;
#undef PG8_SA
#undef PG8_SB
#undef PG8_STAGE
#undef PG8_LDA
#undef PG8_LDB
#undef PG8_MMA
#undef PG8_WAIT_V
#undef PG8_WAIT_L
#undef PG8_BAR
#undef PG8_SCHED
#undef PG8_AOFFS
    }
#undef PG8_ZERO_ACC
}
}

using pg8::Unit;
typedef f32x4 AccT[2][2][4][2];
__device__ __forceinline__ int launder_v(int x) { asm volatile("" : "+v"(x)); return x; }
__device__ __forceinline__ u32x4 pack8(const f32x4 a, const f32x4 b) { u32x4 w; w.x = cvt_pk_bf16(a[0], a[1]); w.y = cvt_pk_bf16(a[2], a[3]); w.z = cvt_pk_bf16(b[0], b[1]); w.w = cvt_pk_bf16(b[2], b[3]); return w; }
__device__ __forceinline__ void st16(char* p, const u32x4 v) { if (NT_STORE) __builtin_nontemporal_store(v, (u32x4*)p); else *(u32x4*)p = v; }
__device__ __forceinline__ f32x4 unlo(const u32x4 g) { return (f32x4){bflo(g.x), bfhi(g.x), bflo(g.y), bfhi(g.y)}; }
__device__ __forceinline__ f32x4 unhi(const u32x4 g) { return (f32x4){bflo(g.z), bfhi(g.z), bflo(g.w), bfhi(g.w)}; }

struct EpiInProj {
    static constexpr bool PERM = true, MID = false;
    unsigned char* ws; const float* bgate; int pn0;
    __device__ __forceinline__ void mid(AccT&, const Unit&, int, int, int, int) const {}
    __device__ __forceinline__ void operator()(const AccT& acc, const Unit& u, int wr, int wc, int fr, int fq) const {
        const int row0 = launder_v(u.pm * 256 + wr * 64 + fr), pn = u.pn + pn0, cl = wc * 32 + 8 * fq;
        if (pn < 8) {
            char* XC = (char*)(ws + WS_XC); const unsigned o0 = ((unsigned)row0 * CW + pn * 128 + cl) * 2u;
#pragma unroll
            for (int ai = 0; ai < 2; ++ai)
#pragma unroll
                for (int m = 0; m < 4; ++m)
                    st16(XC + o0 + (unsigned)((ai * 128 + m * 16) * CW * 2), pack8(acc[ai][0][m][0] * acc[ai][1][m][0], acc[ai][0][m][1] * acc[ai][1][m][1]));
        } else if (pn < 20) {
            const int kind = (pn - 8) >> 2, q = (pn - 8) & 3;
            char* dst = (char*)(ws + (kind == 0 ? WS_BB : (kind == 1 ? WS_U : WS_V))); const unsigned o0 = ((unsigned)row0 * CW + q * 256 + cl) * 2u;
            char* VST = (char*)(ws + WS_VSTAT); const unsigned so = ((unsigned)row0 * 16 + q * 4 + wc) * 8u;
#pragma unroll
            for (int ai = 0; ai < 2; ++ai)
#pragma unroll
                for (int m = 0; m < 4; ++m) { float s = 0.f, sq = 0.f;
#pragma unroll
                    for (int bj = 0; bj < 2; ++bj) { f32x4 v0 = acc[ai][bj][m][0], v1 = acc[ai][bj][m][1];
                        if (kind != 0) { v0 = gelu_tanh4(v0); v1 = gelu_tanh4(v1); }
                        if (kind == 2) {
#pragma unroll
                            for (int j = 0; j < 4; ++j) { s += v0[j] + v1[j]; sq += v0[j] * v0[j] + v1[j] * v1[j]; } }
                        st16(dst + o0 + (unsigned)(((ai * 128 + m * 16) * CW + bj * 128) * 2), pack8(v0, v1)); }
                    if (kind == 2) { s += __shfl_xor(s, 16); s += __shfl_xor(s, 32); sq += __shfl_xor(sq, 16); sq += __shfl_xor(sq, 32);
                        if (fq == 0) *(f32x2*)(VST + so + (unsigned)((ai * 128 + m * 16) * 16 * 8)) = (f32x2){s, sq}; }
                    asm volatile("" ::: "memory"); }
        } else {
            const int d0 = (pn - 20) * 128 + cl;
            char* GR = (char*)(ws + WS_GR); char* GB = (char*)(ws + WS_GB); const unsigned o0 = ((unsigned)((u.pm * 16 + (pn - 20)) * 8 + wr * 4 + wc) * 8u) * 1024u + (unsigned)launder_v(fq * 16 + fr) * 16u;
            f32x4 ba[2], bb[2]; const float NL2E = -1.44269504f, CL = 43.2808512f;
#pragma unroll
            for (int n = 0; n < 2; ++n) { ba[n] = *(const f32x4*)(bgate + d0 + 4 * n) * NL2E; bb[n] = *(const f32x4*)(bgate + D + d0 + 4 * n) * NL2E; }
#pragma unroll
            for (int ai = 0; ai < 2; ++ai)
#pragma unroll
                for (int m = 0; m < 4; ++m) { f32x4 r[2], sb[2];
#pragma unroll
                    for (int n = 0; n < 2; ++n) {
                        f32x4 xa = acc[ai][0][m][n] * NL2E + ba[n], xb = acc[ai][1][m][n] * NL2E + bb[n], ta, tb;
#pragma unroll
                        for (int j = 0; j < 4; ++j) { ta[j] = __builtin_amdgcn_exp2f(__builtin_amdgcn_fmed3f(xa[j], -CL, CL)); tb[j] = __builtin_amdgcn_exp2f(__builtin_amdgcn_fmed3f(xb[j], -CL, CL)); }
                        ta = ta + 1.0f; tb = tb + 1.0f;
                        f32x4 inv = ta * tb;
#pragma unroll
                        for (int j = 0; j < 4; ++j) inv[j] = __builtin_amdgcn_rcpf(inv[j]);
                        sb[n] = ta * (inv * 255.f); r[n] = tb * tb * inv; }
                    const unsigned o = o0 + (unsigned)((ai * 4 + m) * 1024);
                    st16(GR + o, pack8(r[0], r[1]));
                    unsigned q0 = 0u, q1 = 0u;
#pragma unroll
                    for (int j = 0; j < 4; ++j) { q0 = __builtin_amdgcn_cvt_pk_u8_f32(sb[0][j], j, q0); q1 = __builtin_amdgcn_cvt_pk_u8_f32(sb[1][j], j, q1); }
                    *(u32x2*)(GB + (o >> 1)) = (u32x2){q0, q1};
                    asm volatile("" ::: "memory"); }
        }
    }
};

struct EpiBranch {
    static constexpr bool PERM = true, MID = true;
    unsigned char* ws; bool f8out;
    __device__ __forceinline__ void mid(AccT& acc, const Unit& u, int wr, int wc, int fr, int fq) const {
        const char* GR = (const char*)(ws + WS_GR);
        const unsigned o0 = ((unsigned)((u.pm * 16 + 2 * u.pn) * 8 + wr * 4 + wc) * 8u) * 1024u + (unsigned)launder_v(fq * 16 + fr) * 16u;
        u32x4 g[2][4][2];
#pragma unroll
        for (int ai = 0; ai < 2; ++ai)
#pragma unroll
            for (int m = 0; m < 4; ++m)
#pragma unroll
                for (int bj = 0; bj < 2; ++bj) g[ai][m][bj] = *(const u32x4*)(GR + o0 + (unsigned)(bj * 65536 + (ai * 4 + m) * 1024));
#pragma unroll
        for (int ai = 0; ai < 2; ++ai)
#pragma unroll
            for (int m = 0; m < 4; ++m)
#pragma unroll
                for (int bj = 0; bj < 2; ++bj) { acc[ai][bj][m][0] *= unlo(g[ai][m][bj]); acc[ai][bj][m][1] *= unhi(g[ai][m][bj]); }
    }
    __device__ __forceinline__ void operator()(const AccT& acc, const Unit& u, int wr, int wc, int fr, int fq) const {
        const int row0 = launder_v(u.pm * 256 + wr * 64 + fr); const char* GB = (const char*)(ws + WS_GB); char* OUT = (char*)(ws + WS_XN);
        const unsigned o0 = ((unsigned)row0 * D + u.pn * 256 + wc * 32 + 8 * fq);
        const unsigned g0 = ((unsigned)((u.pm * 16 + 2 * u.pn) * 8 + wr * 4 + wc) * 8u) * 1024u + (unsigned)(fq * 16 + fr) * 16u;
        u32x2 g[2][4][2];
#pragma unroll
        for (int ai = 0; ai < 2; ++ai)
#pragma unroll
            for (int m = 0; m < 4; ++m)
#pragma unroll
                for (int bj = 0; bj < 2; ++bj) g[ai][m][bj] = *(const u32x2*)(GB + ((g0 + (unsigned)(bj * 65536 + (ai * 4 + m) * 1024)) >> 1));
#pragma unroll
        for (int ai = 0; ai < 2; ++ai)
#pragma unroll
            for (int m = 0; m < 4; ++m)
#pragma unroll
                for (int bj = 0; bj < 2; ++bj) { const unsigned o = o0 + (unsigned)((ai * 128 + m * 16) * D + bj * 128);
                    const unsigned ga = g[ai][m][bj].x, gb = g[ai][m][bj].y; const float k255 = 1.0f / 255.f;
                    const f32x4 v0 = acc[ai][bj][m][0] * ((f32x4){(float)(ga & 255u), (float)((ga >> 8) & 255u), (float)((ga >> 16) & 255u), (float)(ga >> 24)} * k255),
                                v1 = acc[ai][bj][m][1] * ((f32x4){(float)(gb & 255u), (float)((gb >> 8) & 255u), (float)((gb >> 16) & 255u), (float)(gb >> 24)} * k255);
                    if (f8out) *(u32x2*)(OUT + o) = (u32x2){pk4_fp8(v0[0], v0[1], v0[2], v0[3]), pk4_fp8(v1[0], v1[1], v1[2], v1[3])};
                    else *(u32x4*)(OUT + 2u * o) = pack8(v0, v1); }
    }
};

struct EpiOut {
    static constexpr bool PERM = true, MID = false;
    unsigned char* ws;
    __device__ __forceinline__ void mid(AccT&, const Unit&, int, int, int, int) const {}
    __device__ __forceinline__ void operator()(const AccT& acc, const Unit& u, int wr, int wc, int fr, int fq) const {
        const int row0 = launder_v(u.pm * 256 + wr * 64 + fr); char* Y = (char*)(ws + WS_DELTA);
        const unsigned o0 = ((unsigned)row0 * D + u.pn * 256 + wc * 32 + 8 * fq) * 2u;
#pragma unroll
        for (int ai = 0; ai < 2; ++ai)
#pragma unroll
            for (int m = 0; m < 4; ++m) {
#pragma unroll
                for (int bj = 0; bj < 2; ++bj) *(u32x4*)(Y + o0 + (unsigned)(((ai * 128 + m * 16) * D + bj * 128) * 2)) = pack8(acc[ai][bj][m][0], acc[ai][bj][m][1]);
                asm volatile("" ::: "memory"); }
    }
};

struct EpiGU {
    static constexpr bool PERM = true, MID = false;
    unsigned char* ws;
    __device__ __forceinline__ void mid(AccT&, const Unit&, int, int, int, int) const {}
    __device__ __forceinline__ void operator()(const AccT& acc, const Unit& u, int wr, int wc, int fr, int fq) const {
        const int rl0 = launder_v(wr * 64 + fr); const int row0 = u.pm * 256 + rl0; char* HM = (char*)(ws + WS_HMID);
        const char* RL = (const char*)(ws + WS_TOKLIST); const unsigned rb0 = (unsigned)(u.e * LISTCAP + u.rbl * 256) * 8u + 4u; const int vmax = u.nvalid - 1;
        const unsigned o0 = ((unsigned)row0 * DE + u.pn * 128 + wc * 32 + 8 * fq);
        float rsv[2][4];
#pragma unroll
        for (int ai = 0; ai < 2; ++ai)
#pragma unroll
            for (int m = 0; m < 4; ++m) { int rl = rl0 + ai * 128 + m * 16; rl = rl < vmax ? rl : vmax;
                rsv[ai][m] = *(const float*)(RL + rb0 + (unsigned)rl * 8u); }
#pragma unroll
        for (int ai = 0; ai < 2; ++ai)
#pragma unroll
            for (int m = 0; m < 4; ++m) { const float rs = rsv[ai][m];
                f32x4 h[2];
#pragma unroll
                for (int n = 0; n < 2; ++n) { const f32x4 g = acc[ai][0][m][n] * rs, up = acc[ai][1][m][n] * rs, z = g * -1.44269504f; f32x4 t;
#pragma unroll
                    for (int j = 0; j < 4; ++j) t[j] = __builtin_amdgcn_exp2f(z[j]);
                    t = t + 1.0f;
#pragma unroll
                    for (int j = 0; j < 4; ++j) t[j] = __builtin_amdgcn_rcpf(t[j]);
                    h[n] = (g * t) * up; }
                *(u32x2*)(HM + o0 + (unsigned)((ai * 128 + m * 16) * DE)) = (u32x2){pk4_fp8(h[0][0], h[0][1], h[0][2], h[0][3]), pk4_fp8(h[1][0], h[1][1], h[1][2], h[1][3])};
                asm volatile("" ::: "memory"); }
    }
};

struct EpiDown {
    static constexpr bool PERM = true, MID = false;
    unsigned char* ws; bool f8out;
    __device__ __forceinline__ void mid(AccT&, const Unit&, int, int, int, int) const {}
    __device__ __forceinline__ void operator()(const AccT& acc, const Unit& u, int wr, int wc, int fr, int fq) const {
        const int row0 = launder_v(u.pm * 256 + wr * 64 + fr); char* Y = (char*)(ws + WS_YSLOT);
        const unsigned o0 = ((unsigned)row0 * D + u.pn * 256 + wc * 32 + 8 * fq);
#pragma unroll
        for (int ai = 0; ai < 2; ++ai)
#pragma unroll
            for (int m = 0; m < 4; ++m) {
#pragma unroll
                for (int bj = 0; bj < 2; ++bj) { const unsigned o = o0 + (unsigned)((ai * 128 + m * 16) * D + bj * 128);
                    if (f8out) { f32x4 v0 = acc[ai][bj][m][0] * 16.f, v1 = acc[ai][bj][m][1] * 16.f;
#pragma unroll
                        for (int j = 0; j < 4; ++j) { v0[j] = __builtin_amdgcn_fmed3f(v0[j], -448.f, 448.f); v1[j] = __builtin_amdgcn_fmed3f(v1[j], -448.f, 448.f); }
                        *(u32x2*)(Y + o) = (u32x2){pk4_fp8(v0[0], v0[1], v0[2], v0[3]), pk4_fp8(v1[0], v1[1], v1[2], v1[3])}; }
                    else *(u32x4*)(Y + 2u * o) = pack8(acc[ai][bj][m][0], acc[ai][bj][m][1]); }
                asm volatile("" ::: "memory"); }
    }
};

struct Args { const float* in[20]; float* out; unsigned char* ws; };
#define CAS __attribute__((address_space(4)))
typedef const CAS unsigned char* kptr_t;
__device__ __forceinline__ const float* arg_in(kptr_t kp, int i) { const GAS float* p = *(const GAS float* const CAS*)(kp + 8 * i); return (const float*)p; }
__device__ __forceinline__ float* arg_out(kptr_t kp) { GAS float* p = *(GAS float* const CAS*)(kp + 160); return (float*)p; }
__device__ __forceinline__ unsigned char* arg_ws(kptr_t kp) { GAS unsigned char* p = *(GAS unsigned char* const CAS*)(kp + 168); return (unsigned char*)p; }
struct Frame {
    LAS unsigned char* lds; volatile LAS unsigned* MISC; unsigned* ctl;
    int tid, lane, wave, vcu, G;
    kptr_t kp; float* out; unsigned char* ws;
};
__device__ __forceinline__ int launder_s(int x) { asm volatile("" : "+s"(x)); return x; }
__device__ __forceinline__ kptr_t launder_k(kptr_t p) { asm volatile("" : "+s"(p)); return p; }
__device__ __forceinline__ void phase_frame(const struct Frame& F, struct Frame& P);
enum { I_X = 0, I_N1G, I_WIN, I_BGATE, I_CONVW, I_LNVG, I_LNVB, I_SGUW, I_SGUB, I_WBR, I_WOUT, I_N2G, I_RG, I_RGB, I_RE, I_REB, I_WGATE, I_WUP, I_WDOWN, I_FG };

__device__ __forceinline__ void phase_frame(const Frame& F, Frame& P) {
    P = F; P.wave = launder_s(F.wave); { int ln_; asm volatile("v_mbcnt_lo_u32_b32 %0, -1, 0\n\tv_mbcnt_hi_u32_b32 %0, -1, %0" : "=&v"(ln_)); P.lane = ln_; } P.tid = P.wave * 64 + P.lane;     P.kp = launder_k(F.kp); P.ws = arg_ws(P.kp); P.out = arg_out(P.kp); P.ctl = (unsigned*)(P.ws + WS_CTL); P.vcu = launder_s(F.vcu);
}
__device__ __forceinline__ int win_map(int n0) {
    if (n0 < 1024) return 256 * (n0 >> 7) + (n0 & 127);
    if (n0 < 2048) return 256 * 8 + (n0 - 1024);
    if (n0 < 3072) { const int j = n0 - 2048; return 256 * (j >> 7) + 128 + (j & 127); }
    if (n0 < 4096) return 256 * 12 + (n0 - 3072);
    if (n0 < 5120) return 256 * 16 + (n0 - 4096);
    if (n0 < 7168) { const int d = n0 - 5120; return 256 * 20 + 256 * (d >> 7) + (d & 127); }
    { const int d = n0 - 7168; return 256 * 20 + 256 * (d >> 7) + 128 + (d & 127); }
}
struct TrItem { const float* src; bf16* dst; int N, ldk, kcol0, k0, n0, drow0, f8; };
constexpr int IT_WIN = 32 * 144, IT_WBR = 16 * 32, IT_WOUT = 32 * 32, IT_EXP = 256, IT_LAYER = IT_WIN + 2 * IT_WBR + IT_WOUT + 3 * 32 * IT_EXP, IT_TOTAL = DEPTH * IT_LAYER;
__device__ __forceinline__ void p0_decode(const Frame& F, int it, TrItem& t) {
    const int l = it / IT_LAYER; int r = it - l * IT_LAYER;
    unsigned char* ws = F.ws;
    if (r < IT_WIN) { const int kb = r / 144, nb = r - kb * 144; t.src = arg_in(F.kp, I_WIN) + (size_t)l * D * DIN; t.N = DIN; t.ldk = D; t.kcol0 = 0; t.k0 = kb * 64; t.n0 = nb * 64;
        const int dr = win_map(nb * 64), split = l >= G1_F8_FROM ? G1_SPLIT : 5120;
        if (dr < split) { t.dst = (bf16*)(ws + WS_WIN) + (size_t)l * DIN * D; t.drow0 = dr; t.f8 = 0; }
        else { t.dst = (bf16*)(ws + WS_WIN8 + (size_t)l * 6144 * D); t.drow0 = dr - split; t.f8 = 1; }
        return; }
    r -= IT_WIN;
    if (r < 2 * IT_WBR) { const int br = r / IT_WBR; r -= br * IT_WBR; const int kb = r >> 5, nb = r & 31; t.src = arg_in(F.kp, I_WBR) + (size_t)(l * 2 + br) * CW * D; t.N = D; t.dst = (bf16*)(ws + WS_WBR) + (size_t)l * D * D; t.ldk = D; t.kcol0 = br * CW; t.k0 = kb * 64; t.n0 = nb * 64; t.drow0 = nb * 64; t.f8 = (l >= G2_F8_FROM); return; }
    r -= 2 * IT_WBR;
    if (r < IT_WOUT) { const int kb = r >> 5, nb = r & 31; t.src = arg_in(F.kp, I_WOUT) + (size_t)l * D * D; t.N = D; t.dst = (bf16*)(ws + WS_WOUT) + (size_t)l * D * D; t.ldk = D; t.kcol0 = 0; t.k0 = kb * 64; t.n0 = nb * 64; t.drow0 = nb * 64; t.f8 = (l >= G3_F8_FROM); return; }
    r -= IT_WOUT;
    const int type = r / (32 * IT_EXP); r -= type * 32 * IT_EXP; const int e = r / IT_EXP; r -= e * IT_EXP;
    if (type < 2) { const int kb = r >> 3, nb = r & 7, n0 = nb * 64; t.src = (type == 0 ? arg_in(F.kp, I_WGATE) : arg_in(F.kp, I_WUP)) + (size_t)(l * NE + e) * D * DE; t.N = DE; t.dst = (bf16*)(ws + WS_WGU + (size_t)(l * NE + e) * 1024 * D); t.ldk = D; t.kcol0 = 0; t.k0 = kb * 64; t.n0 = n0; t.f8 = 1;
        t.drow0 = 256 * (n0 >> 7) + (type == 1 ? 128 : 0) + (n0 & 127); return; }
    { const int kb = r >> 5, nb = r & 31; t.src = arg_in(F.kp, I_WDOWN) + (size_t)(l * NE + e) * DE * D; t.N = D; t.dst = (bf16*)(ws + WS_WD + (size_t)(l * NE + e) * D * DE); t.ldk = DE; t.kcol0 = 0; t.k0 = kb * 64; t.n0 = nb * 64; t.drow0 = nb * 64; t.f8 = 1; }
}
__device__ __forceinline__ void p0_load(const TrItem& t, int lane, float (&v)[64]) {
    const float* p = t.src + (size_t)t.k0 * t.N + t.n0 + lane;
#pragma unroll
    for (int i = 0; i < 64; ++i) v[i] = __builtin_nontemporal_load(p + (size_t)i * t.N);
}

__device__ __forceinline__ f32x4 ydec_lo(const u32x4 y) { return unlo(y); }
__device__ __forceinline__ f32x4 ydec_hi(const u32x4 y) { return unhi(y); }
__device__ __forceinline__ f32x4 ydec_lo(const u32x2 y) { const f32x2 a = __builtin_amdgcn_cvt_pk_f32_fp8((int)y.x, false), b = __builtin_amdgcn_cvt_pk_f32_fp8((int)y.x, true); return (f32x4){a.x, a.y, b.x, b.y}; }
__device__ __forceinline__ f32x4 ydec_hi(const u32x2 y) { const f32x2 a = __builtin_amdgcn_cvt_pk_f32_fp8((int)y.y, false), b = __builtin_amdgcn_cvt_pk_f32_fp8((int)y.y, true); return (f32x4){a.x, a.y, b.x, b.y}; }
template <bool Y8> struct YRow { typedef u32x4 T; };
template <> struct YRow<true> { typedef u32x2 T; };
template <int MODE> __device__ __forceinline__ void row_pass(const Frame& F, const float* gain) {
    const int lane = F.lane; const int gw = F.wave * F.G + F.vcu, NGW = F.G * NWAVES;
    const float* src = arg_in(F.kp, I_X); const bf16* Hs = (const bf16*)(F.ws + (MODE == 2 ? WS_H1 : WS_H)); bf16* Hd = (bf16*)(F.ws + (MODE == 0 ? WS_H : WS_H1));
    const bf16* DL = (const bf16*)(F.ws + WS_DELTA);
    bf16* XN = (bf16*)(F.ws + WS_XN);
    constexpr bool Y8 = (MODE == 2 ? DEPTH - 1 : 0) >= YS_F8_FROM;
    typedef typename YRow<Y8>::T YT; constexpr int YB = Y8 ? 1 : 2;
    const unsigned char* Y = F.ws + WS_YSLOT; const float ysc = Y8 ? 0.0625f : 1.0f;
    const LAS int* rbs = (const LAS int*)(F.lds + MISC_OFF + 64);
    f32x4 g[4][2];
#pragma unroll
    for (int j = 0; j < 4; ++j) { g[j][0] = *(const f32x4*)(gain + 512 * j + 8 * lane); g[j][1] = *(const f32x4*)(gain + 512 * j + 8 * lane + 4); }
    f32x4 hA[4][2], hB[4][2]; u32x4 rA[4], rB[4]; u32x4 dA[4], dB[4]; YT yA0[4], yA1[4], yB0[4], yB1[4]; f32x2 wA = (f32x2){0.f, 0.f}, wB = (f32x2){0.f, 0.f};
    u32x4 rec = (u32x4){0u, 0u, 0u, 0u}; f32x2 recw = (f32x2){0.f, 0.f};
#define RP_REC(row_) do { if (MODE != 0 && (row_) < NTOK) { rec = *(const u32x4*)(F.ws + WS_TOKINFO + (size_t)(row_) * 32); recw = *(const f32x2*)(F.ws + WS_TOKINFO + (size_t)(row_) * 32 + 16); } } while (0)
#define RP_LOAD(h_, r_, d_, y0_, y1_, w_, row_) do { if ((row_) < NTOK) { \
        _Pragma("unroll") for (int j = 0; j < 4; ++j) { \
            if constexpr (MODE == 0) { h_[j][0] = *(const f32x4*)(src + (size_t)(row_) * D + 512 * j + 8 * lane); h_[j][1] = *(const f32x4*)(src + (size_t)(row_) * D + 512 * j + 8 * lane + 4); } \
            else r_[j] = *(const u32x4*)(Hs + (size_t)(row_) * D + 512 * j + 8 * lane); } \
        if constexpr (MODE != 0) { const int s0 = 256 * rbs[rec.x] + (int)rec.y, s1 = 256 * rbs[rec.z] + (int)rec.w; w_ = recw * ysc; \
            _Pragma("unroll") for (int j = 0; j < 4; ++j) { d_[j] = *(const u32x4*)(DL + (size_t)(row_) * D + 512 * j + 8 * lane); \
                y0_[j] = *(const YT*)(Y + ((size_t)s0 * D + 512 * j + 8 * lane) * YB); y1_[j] = *(const YT*)(Y + ((size_t)s1 * D + 512 * j + 8 * lane) * YB); } } } } while (0)
#define RP_DO(h_, r_, d_, y0_, y1_, w_, row_) do { \
        if constexpr (MODE != 0) { _Pragma("unroll") for (int j = 0; j < 4; ++j) { \
            h_[j][0] = unlo(r_[j]) + unlo(d_[j]) + w_.x * ydec_lo(y0_[j]) + w_.y * ydec_lo(y1_[j]); h_[j][1] = unhi(r_[j]) + unhi(d_[j]) + w_.x * ydec_hi(y0_[j]) + w_.y * ydec_hi(y1_[j]); } } \
        float ss = 0.f; \
        _Pragma("unroll") for (int j = 0; j < 4; ++j) _Pragma("unroll") for (int q = 0; q < 2; ++q) ss += (h_[j][q][0] * h_[j][q][0] + h_[j][q][1] * h_[j][q][1]) + (h_[j][q][2] * h_[j][q][2] + h_[j][q][3] * h_[j][q][3]); \
        const float rstd = 1.0f / sqrtf(wave_sum(ss) * (1.0f / D) + EPS); \
        _Pragma("unroll") for (int j = 0; j < 4; ++j) { \
            if constexpr (MODE != 2) *(u32x4*)(Hd + (size_t)(row_) * D + 512 * j + 8 * lane) = pack8(h_[j][0], h_[j][1]); \
            const f32x4 o0 = h_[j][0] * rstd * g[j][0], o1 = h_[j][1] * rstd * g[j][1]; \
            if constexpr (MODE == 2) { *(f32x4*)(F.out + (size_t)(row_) * D + 512 * j + 8 * lane) = o0; *(f32x4*)(F.out + (size_t)(row_) * D + 512 * j + 8 * lane + 4) = o1; } \
            else { *(u32x4*)(XN + (size_t)(row_) * D + 512 * j + 8 * lane) = pack8(o0, o1); \
                *(u32x2*)(F.ws + WS_XN8 + (size_t)(row_) * D + 512 * j + 8 * lane) = (u32x2){pk4_fp8(o0[0], o0[1], o0[2], o0[3]), pk4_fp8(o1[0], o1[1], o1[2], o1[3])}; } } } while (0)
    RP_REC(gw);
    RP_LOAD(hA, rA, dA, yA0, yA1, wA, gw);
    RP_REC(gw + NGW);
#pragma unroll 1
    for (int row = gw; row < NTOK; row += 2 * NGW) {
        RP_LOAD(hB, rB, dB, yB0, yB1, wB, row + NGW);
        RP_REC(row + 2 * NGW);
        RP_DO(hA, rA, dA, yA0, yA1, wA, row);
        if (row + NGW < NTOK) {
            RP_LOAD(hA, rA, dA, yA0, yA1, wA, row + 2 * NGW);
            RP_REC(row + 3 * NGW);
            RP_DO(hB, rB, dB, yB0, yB1, wB, row + NGW);
        }
    }
#undef RP_REC
#undef RP_LOAD
#undef RP_DO
}

template <int PM  > __device__ __forceinline__ void p0_prologue(const Frame& F) {
    LAS float* scr = (LAS float*)(F.lds + F.wave * P0_SCR);
    const int lane = F.lane, gw = F.vcu * NWAVES + F.wave, NGW = F.G * NWAVES;
    {
        TrItem cur, nxt; float v[64];
        int it = gw; bool have = it < IT_TOTAL;
        if (have) { p0_decode(F, it, cur); p0_load(cur, lane, v); }
#pragma unroll 1
        while (have) {
#pragma unroll
            for (int i = 0; i < 64; ++i) scr[i * 65 + lane] = v[i];
            LDS_WAIT(); asm volatile("" ::: "memory");
            const int itn = it + NGW; const bool haven = itn < IT_TOTAL;
            if (haven) { p0_decode(F, itn, nxt); p0_load(nxt, lane, v); }
            const int c = lane & 7;
#pragma unroll
            for (int j = 0; j < 8; ++j) { const int n = (lane >> 3) + 8 * j; const LAS float* s = scr + (8 * c) * 65 + n;
                const size_t eo = (size_t)(cur.drow0 + n) * cur.ldk + cur.kcol0 + cur.k0 + 8 * c;
                if (cur.f8) { u32x2 o; o.x = pk4_fp8(32.f * s[0 * 65], 32.f * s[1 * 65], 32.f * s[2 * 65], 32.f * s[3 * 65]); o.y = pk4_fp8(32.f * s[4 * 65], 32.f * s[5 * 65], 32.f * s[6 * 65], 32.f * s[7 * 65]);
                    __builtin_nontemporal_store(o, (u32x2*)((unsigned char*)cur.dst + eo)); }
                else { u32x4 o; o.x = cvt_pk_bf16(s[0 * 65], s[1 * 65]); o.y = cvt_pk_bf16(s[2 * 65], s[3 * 65]); o.z = cvt_pk_bf16(s[4 * 65], s[5 * 65]); o.w = cvt_pk_bf16(s[6 * 65], s[7 * 65]);
                    __builtin_nontemporal_store(o, (u32x4*)(cur.dst + eo)); } }
            LDS_WAIT(); asm volatile("" ::: "memory");
            cur = nxt; it = itn; have = haven;
        }
    }
    if (PM == 0) {
        bf16* RT = (bf16*)(F.ws + WS_RT);
        for (int idx = (F.vcu * NWAVES + F.wave) * 64 + lane; idx < DEPTH * 48 * D; idx += NGW * 64) {
            const int l = idx / (48 * D), r = idx - l * 48 * D, e = r / D, k = r - e * D;
            float w = 0.f; if (e < 4) w = arg_in(F.kp, I_RG)[(size_t)(l * D + k) * NGRP + e]; else if (e < 36) w = arg_in(F.kp, I_RE)[(size_t)(l * D + k) * NE + (e - 4)];
            const unsigned hi = cvt_pk_bf16(w, 0.f) & 0xffffu; const float rem = w - __uint_as_float(hi << 16); const unsigned lo = cvt_pk_bf16(rem, 0.f) & 0xffffu;
            RT[(size_t)(l * 2 + 0) * 48 * D + r] = (bf16)hi; RT[(size_t)(l * 2 + 1) * 48 * D + r] = (bf16)lo;
        }
    }
    if (PM == 0) row_pass<0>(F, arg_in(F.kp, I_N1G));
}

__device__ __forceinline__ void mid_phase(const Frame& F, int l) {
    LAS bf16* WL = (LAS bf16*)F.lds;
    LAS bf16* VT = (LAS bf16*)(F.lds + 34816);
    LAS float* ST = (LAS float*)(F.lds + 69632);
    LAS bf16* MX = (LAS bf16*)(F.lds + 70656);
    const int tid = F.tid, lane = F.lane, w = F.wave, fr = lane & 15, fq = lane >> 4; const bool f8 = l >= G2_F8_FROM;
    const bf16* XC = (const bf16*)(F.ws + WS_XC); const bf16* BB = (const bf16*)(F.ws + WS_BB); const bf16* U = (const bf16*)(F.ws + WS_U); const bf16* V = (const bf16*)(F.ws + WS_V);
    const f32x2* VST = (const f32x2*)(F.ws + WS_VSTAT); bf16* YAB = (bf16*)(F.ws + WS_YAB);
    const int per = (1024 + F.G - 1) / F.G; const int it0 = F.vcu * per, it1 = (it0 + per) < 1024 ? (it0 + per) : 1024;
    int gcur = -1;
    const int cc = (tid & 15) * 8;
#pragma unroll 1
    for (int it = it0; it < it1; ++it) {
        const int g = it >> 7, ch = it & 127, row0 = ch * CHUNK;
        f32x4 w0[2], w1[2], w2[2], lg0, lg1, lb0, lb1; float sbv[8];
        {
            const float* cw = arg_in(F.kp, I_CONVW) + (size_t)l * 3 * CW + g * 128 + cc;
#pragma unroll
            for (int q = 0; q < 2; ++q) { w0[q] = *(const f32x4*)(cw + 4 * q); w1[q] = *(const f32x4*)(cw + CW + 4 * q); w2[q] = *(const f32x4*)(cw + 2 * CW + 4 * q); }
        }
        u32x4 X0[4], X1[4], X2[4], BBv[4], Vv[4], UU[4]; f32x2 SP[16];
        {
            const u32x4 z = (u32x4){0u, 0u, 0u, 0u};
#pragma unroll
            for (int i = 0; i < 4; ++i) { const int t = (tid >> 4) + 32 * i, row = row0 + t, ts = row & (SEQ - 1); const size_t o = (size_t)row * CW + g * 128 + cc;
                X0[i] = *(const u32x4*)(XC + o); X1[i] = ts >= 1 ? *(const u32x4*)(XC + o - CW) : z; X2[i] = ts >= 2 ? *(const u32x4*)(XC + o - 2 * CW) : z; BBv[i] = *(const u32x4*)(BB + o); }
            if (tid < 128) {
#pragma unroll
                for (int i = 0; i < 16; ++i) SP[i] = VST[(size_t)(row0 + tid) * 16 + i]; }
#pragma unroll
            for (int i = 0; i < 4; ++i) Vv[i] = *(const u32x4*)(V + (size_t)(row0 + (tid >> 4) + 32 * i) * CW + g * 128 + cc);
#pragma unroll
            for (int i = 0; i < 4; ++i) UU[i] = *(const u32x4*)(U + (size_t)(row0 + (tid >> 4) + 32 * i) * CW + g * 128 + cc);
        }
        {
#pragma unroll
            for (int i = 0; i < 4; ++i) { const int t = (tid >> 4) + 32 * i, row = row0 + t;
                const unsigned A0[4] = {X0[i].x, X0[i].y, X0[i].z, X0[i].w}, A1[4] = {X1[i].x, X1[i].y, X1[i].z, X1[i].w}, A2[4] = {X2[i].x, X2[i].y, X2[i].z, X2[i].w}, Bq[4] = {BBv[i].x, BBv[i].y, BBv[i].z, BBv[i].w};
                float yl[4], yh[4];
#pragma unroll
                for (int p = 0; p < 4; ++p) { const int q = p >> 1, e = (p & 1) * 2;
                    yl[p] = bflo(Bq[p]) * (w0[q][e] * bflo(A2[p]) + w1[q][e] * bflo(A1[p]) + w2[q][e] * bflo(A0[p]));
                    yh[p] = bfhi(Bq[p]) * (w0[q][e + 1] * bfhi(A2[p]) + w1[q][e + 1] * bfhi(A1[p]) + w2[q][e + 1] * bfhi(A0[p])); }
                if (f8) {
#pragma unroll
                    for (int p = 0; p < 4; ++p) { yl[p] = __builtin_amdgcn_fmed3f(yl[p], -448.f, 448.f); yh[p] = __builtin_amdgcn_fmed3f(yh[p], -448.f, 448.f); }
                    *(u32x2*)((unsigned char*)YAB + (size_t)row * D + g * 128 + cc) = (u32x2){pk4_fp8(yl[0], yh[0], yl[1], yh[1]), pk4_fp8(yl[2], yh[2], yl[3], yh[3])}; }
                else *(u32x4*)(YAB + (size_t)row * D + g * 128 + cc) = (u32x4){cvt_pk_bf16(yl[0], yh[0]), cvt_pk_bf16(yl[1], yh[1]), cvt_pk_bf16(yl[2], yh[2]), cvt_pk_bf16(yl[3], yh[3])}; }
        }
        {
            const float* lg = arg_in(F.kp, I_LNVG) + l * CW + g * 128 + cc; const float* lb = arg_in(F.kp, I_LNVB) + l * CW + g * 128 + cc;
            lg0 = *(const f32x4*)lg; lg1 = *(const f32x4*)(lg + 4); lb0 = *(const f32x4*)lb; lb1 = *(const f32x4*)(lb + 4);
            const float* sb = arg_in(F.kp, I_SGUB) + (size_t)(l * SG + g) * CHUNK;
#pragma unroll
            for (int tt = 0; tt < 8; ++tt) sbv[tt] = sb[16 * tt + fr];
        }
        __syncthreads();
        if (g != gcur) {
            const float* Wg = arg_in(F.kp, I_SGUW) + (size_t)(l * SG + g) * CHUNK * CHUNK;
#pragma unroll
            for (int i = 0; i < 8; ++i) { const int idx4 = tid + 512 * i, t = idx4 >> 5, s4 = (idx4 & 31) * 4; const f32x4 wv = *(const f32x4*)(Wg + t * CHUNK + s4);
                u32x2 o; o.x = cvt_pk_bf16(s4 + 0 <= t ? wv[0] : 0.f, s4 + 1 <= t ? wv[1] : 0.f); o.y = cvt_pk_bf16(s4 + 2 <= t ? wv[2] : 0.f, s4 + 3 <= t ? wv[3] : 0.f);
                *(LAS u32x2*)(WL + t * 136 + s4) = o; }
            gcur = g;
        }
        if (tid < 128) { float s = 0.f, q = 0.f;
#pragma unroll
            for (int i = 0; i < 16; ++i) { s += SP[i].x; q += SP[i].y; }
            const float mu = s * (1.0f / CW), var = q * (1.0f / CW) - mu * mu; ST[tid * 2] = mu; ST[tid * 2 + 1] = 1.0f / sqrtf(fmaxf(var, 0.f) + EPS); }
        __syncthreads();
        {
#pragma unroll
            for (int i = 0; i < 4; ++i) { const int s = (tid >> 4) + 32 * i; const u32x4 v = Vv[i];
                const float mu = ST[s * 2], rs = ST[s * 2 + 1];
                const float x[8] = {bflo(v.x), bfhi(v.x), bflo(v.y), bfhi(v.y), bflo(v.z), bfhi(v.z), bflo(v.w), bfhi(v.w)};
                float y[8];
#pragma unroll
                for (int j = 0; j < 8; ++j) { const float lgj = j < 4 ? lg0[j & 3] : lg1[j & 3], lbj = j < 4 ? lb0[j & 3] : lb1[j & 3]; y[j] = (x[j] - mu) * rs * lgj + lbj; }
                *(LAS u32x4*)(VT + s * 136 + cc) = (u32x4){cvt_pk_bf16(y[0], y[1]), cvt_pk_bf16(y[2], y[3]), cvt_pk_bf16(y[4], y[5]), cvt_pk_bf16(y[6], y[7])}; }
        }
        __syncthreads();
        {
            typedef short s16x4 __attribute__((ext_vector_type(4)));
            bf16x8 a[4];
            const LAS bf16* tp = VT + (8 * fq + (fr >> 2)) * 136 + 16 * w + 4 * (fr & 3);
#pragma unroll
            for (int ks = 0; ks < 4; ++ks) { const s16x4 lo4 = __builtin_amdgcn_ds_read_tr16_b64_v4i16((LAS s16x4*)(tp + 32 * ks * 136)), hi4 = __builtin_amdgcn_ds_read_tr16_b64_v4i16((LAS s16x4*)(tp + (32 * ks + 4) * 136));
                a[ks] = __builtin_shufflevector(lo4, hi4, 0, 1, 2, 3, 4, 5, 6, 7); }
#pragma unroll
            for (int tt = 0; tt < 8; ++tt) { f32x4 d = (f32x4){0.f, 0.f, 0.f, 0.f};
#pragma unroll
                for (int ks = 0; ks < 4; ++ks) if (32 * ks <= 16 * tt + 15) { const bf16x8 b = *(const LAS bf16x8*)(WL + (16 * tt + fr) * 136 + 32 * ks + 8 * fq); d = __builtin_amdgcn_mfma_f32_16x16x32_bf16(a[ks], b, d, 0, 0, 0); }
                const int t = 16 * tt + fr; const float bias = sbv[tt];
                *(LAS u32x2*)(MX + t * 136 + 16 * w + 4 * fq) = (u32x2){cvt_pk_bf16(d[0] + bias, d[1] + bias), cvt_pk_bf16(d[2] + bias, d[3] + bias)}; }
        }
        __syncthreads();
        {
#pragma unroll
            for (int i = 0; i < 4; ++i) { const int t = (tid >> 4) + 32 * i; const u32x4 mx = *(const LAS u32x4*)(MX + t * 136 + cc), uu = UU[i];
                float y[8] = {bflo(uu.x) * bflo(mx.x), bfhi(uu.x) * bfhi(mx.x), bflo(uu.y) * bflo(mx.y), bfhi(uu.y) * bfhi(mx.y), bflo(uu.z) * bflo(mx.z), bfhi(uu.z) * bfhi(mx.z), bflo(uu.w) * bflo(mx.w), bfhi(uu.w) * bfhi(mx.w)};
                if (f8) {
#pragma unroll
                    for (int j = 0; j < 8; ++j) y[j] = __builtin_amdgcn_fmed3f(y[j], -448.f, 448.f);
                    *(u32x2*)((unsigned char*)YAB + (size_t)(row0 + t) * D + CW + g * 128 + cc) = (u32x2){pk4_fp8(y[0], y[1], y[2], y[3]), pk4_fp8(y[4], y[5], y[6], y[7])}; }
                else *(u32x4*)(YAB + (size_t)(row0 + t) * D + CW + g * 128 + cc) = (u32x4){cvt_pk_bf16(y[0], y[1]), cvt_pk_bf16(y[2], y[3]), cvt_pk_bf16(y[4], y[5]), cvt_pk_bf16(y[6], y[7])}; }
        }
    }
    __syncthreads();
}

__device__ __forceinline__ void r2_phase(const Frame& F, int l, bool dry = false) {
    const int tid = F.tid, lane = F.lane, fr = lane & 15, fq = lane >> 4, pr = F.wave >> 1, kh = F.wave & 1;
    const bf16* H = (const bf16*)(F.ws + (l == 0 ? WS_H : WS_H1)); const bf16* DL = (const bf16*)(F.ws + WS_DELTA); unsigned char* XU8 = F.ws + WS_XN;
    const bf16* RTH = (const bf16*)(F.ws + WS_RT) + (size_t)(l * 2 + 0) * 48 * D; const bf16* RTL = (const bf16*)(F.ws + WS_RT) + (size_t)(l * 2 + 1) * 48 * D;
    const float* gain = arg_in(F.kp, I_N2G) + (size_t)l * D;
    constexpr int HBB = 64 * 272, DBB = 64 * 272;
    LAS float* GAIN = (LAS float*)F.lds;
    LAS unsigned char* HB = F.lds + 8192;
    LAS unsigned char* DB = F.lds + 8192 + 2 * HBB;
    LAS float* LG = (LAS float*)(F.lds + 8192 + F.wave * 4096);
    unsigned* cnt = F.ctl + CW_CNT + (l + (dry ? 2 : 0)) * 32 * 64; unsigned* toklist = (unsigned*)(F.ws + WS_TOKLIST);
    *(LAS f32x4*)(GAIN + 4 * tid) = *(const f32x4*)(gain + 4 * tid);
    float rgb[4], reb[32];
#pragma unroll
    for (int i = 0; i < 4; ++i) rgb[i] = arg_in(F.kp, I_RGB)[l * NGRP + i];
#pragma unroll
    for (int i = 0; i < 32; ++i) reb[i] = arg_in(F.kp, I_REB)[l * NE + i];
    const bf16* bh = RTH + (size_t)fr * D + 8 * fq; const bf16* bl = RTL + (size_t)fr * D + 8 * fq;
#pragma unroll 1
    for (int tg = F.vcu; tg < NTOK / 64; tg += F.G) {
        const int rowb = tg * 64, row0 = rowb + pr * 16;
        f32x4 acc[3] = {(f32x4){0.f, 0.f, 0.f, 0.f}, (f32x4){0.f, 0.f, 0.f, 0.f}, (f32x4){0.f, 0.f, 0.f, 0.f}};
        float ss = 0.f;
        const bf16* hsrc = H + (size_t)(rowb + (tid >> 4)) * D + 8 * (tid & 15); const bf16* dsrc = DL + (size_t)(rowb + (tid >> 4)) * D + 8 * (tid & 15);
        const int ddst = (tid >> 4) * 272 + (tid & 15) * 16, hdst = ddst;
        u32x4 hrE[2], drE[2], hrO[2], drO[2];
#define R2_BLOAD(BH, BL, kc_) do { const int kg0_ = (kc_) * 128 + 64 * kh; \
            _Pragma("unroll") for (int j = 0; j < 2; ++j) _Pragma("unroll") for (int eb = 0; eb < 3; ++eb) { BH[j][eb] = *(const bf16x8*)(bh + (size_t)(16 * eb) * D + kg0_ + 32 * j); if (ROUTER_SPLIT) BL[j][eb] = *(const bf16x8*)(bl + (size_t)(16 * eb) * D + kg0_ + 32 * j); } } while (0)
#define R2_HLOAD(hr, dr, kc_) do { _Pragma("unroll") for (int i = 0; i < 2; ++i) { hr[i] = *(const u32x4*)(hsrc + (size_t)(32 * i) * D + (kc_) * 128); dr[i] = *(const u32x4*)(dsrc + (size_t)(32 * i) * D + (kc_) * 128); } } while (0)
#define R2_HPUT(hr, dr, buf_) do { _Pragma("unroll") for (int i = 0; i < 2; ++i) { *(LAS u32x4*)(HB + (buf_) * HBB + hdst + i * 32 * 272) = hr[i]; *(LAS u32x4*)(DB + (buf_) * DBB + ddst + i * 32 * 272) = dr[i]; } } while (0)
        bf16x8 BHa[2][3], BLa[2][3], BHb[2][3], BLb[2][3];
        R2_HLOAD(hrE, drE, 0);
        __syncthreads();
        R2_HPUT(hrE, drE, 0);
        R2_BLOAD(BHa, BLa, 0);
        R2_HLOAD(hrO, drO, 1);
        __syncthreads();
#define R2_COMPUTE(BH, BL, kc_, buf_) do { \
            const int kg0 = (kc_) * 128 + 64 * kh; u32x2 Q[2]; \
            _Pragma("unroll") for (int j = 0; j < 2; ++j) { \
                const int kl = 64 * kh + 32 * j + 8 * fq; \
                const LAS unsigned char* hp = HB + (buf_) * HBB + (pr * 16 + fr) * 272 + kl * 2; const LAS unsigned char* dp = DB + (buf_) * DBB + (pr * 16 + fr) * 272 + kl * 2; \
                const u32x4 hv = *(const LAS u32x4*)hp; const f32x4 H0 = unlo(hv), H1 = unhi(hv); const u32x4 dl = *(const LAS u32x4*)dp; \
                const f32x4 G0 = *(const LAS f32x4*)(GAIN + (kc_) * 128 + kl), G1 = *(const LAS f32x4*)(GAIN + (kc_) * 128 + kl + 4); \
                const f32x4 h0 = H0 + unlo(dl), h1 = H1 + unhi(dl); \
                ss += (h0[0] * h0[0] + h0[1] * h0[1]) + (h0[2] * h0[2] + h0[3] * h0[3]) + (h1[0] * h1[0] + h1[1] * h1[1]) + (h1[2] * h1[2] + h1[3] * h1[3]); \
                const f32x4 x0 = h0 * G0, x1 = h1 * G1; \
                u32x4 hi; hi.x = cvt_pk_bf16(x0[0], x0[1]); hi.y = cvt_pk_bf16(x0[2], x0[3]); hi.z = cvt_pk_bf16(x1[0], x1[1]); hi.w = cvt_pk_bf16(x1[2], x1[3]); \
                Q[j] = (u32x2){pk4_fp8(x0[0], x0[1], x0[2], x0[3]), pk4_fp8(x1[0], x1[1], x1[2], x1[3])}; \
                const bf16x8 Ah = __builtin_bit_cast(bf16x8, hi); \
                if (ROUTER_SPLIT) { u32x4 lo; lo.x = cvt_pk_bf16(x0[0] - bflo(hi.x), x0[1] - bfhi(hi.x)); lo.y = cvt_pk_bf16(x0[2] - bflo(hi.y), x0[3] - bfhi(hi.y)); \
                    lo.z = cvt_pk_bf16(x1[0] - bflo(hi.z), x1[1] - bfhi(hi.z)); lo.w = cvt_pk_bf16(x1[2] - bflo(hi.w), x1[3] - bfhi(hi.w)); const bf16x8 Al = __builtin_bit_cast(bf16x8, lo); \
                    _Pragma("unroll") for (int eb = 0; eb < 3; ++eb) { acc[eb] = __builtin_amdgcn_mfma_f32_16x16x32_bf16(Al, BH[j][eb], acc[eb], 0, 0, 0); acc[eb] = __builtin_amdgcn_mfma_f32_16x16x32_bf16(Ah, BL[j][eb], acc[eb], 0, 0, 0); } } \
                _Pragma("unroll") for (int eb = 0; eb < 3; ++eb) acc[eb] = __builtin_amdgcn_mfma_f32_16x16x32_bf16(Ah, BH[j][eb], acc[eb], 0, 0, 0); } \
            _Pragma("unroll") for (int j = 0; j < 2; ++j) *(u32x2*)(XU8 + (size_t)(row0 + fr) * D + kg0 + 32 * j + 8 * fq) = Q[j]; } while (0)
#pragma unroll 1
        for (int kc = 0; kc < 16; kc += 2) {
            const int k2 = kc + 2 < 16 ? kc + 2 : 15, k3 = kc + 3 < 16 ? kc + 3 : 15;
            R2_BLOAD(BHb, BLb, kc + 1);
            R2_HLOAD(hrE, drE, k2);
            asm volatile("" ::: "memory");
            R2_COMPUTE(BHa, BLa, kc, 0);
            R2_HPUT(hrO, drO, 1);
            __syncthreads();
            R2_BLOAD(BHa, BLa, k2);
            R2_HLOAD(hrO, drO, k3);
            asm volatile("" ::: "memory");
            R2_COMPUTE(BHb, BLb, kc + 1, 1);
            R2_HPUT(hrE, drE, 0);
            __syncthreads();
        }
#undef R2_BLOAD
#undef R2_HLOAD
#undef R2_HPUT
#undef R2_COMPUTE
        if (tid < 32) F.MISC[640 + tid] = 0u;
        ss += __shfl_xor(ss, 16); ss += __shfl_xor(ss, 32);
#pragma unroll
        for (int eb = 0; eb < 3; ++eb)
#pragma unroll
            for (int j = 0; j < 4; ++j) LG[(4 * fq + j) * 48 + 16 * eb + fr] = acc[eb][j];
        if (fq == 0) LG[768 + fr] = ss;
        __syncthreads();
        const bool router = (kh == 0 && lane < 16);
        int row = 0, e1 = 0, e2 = 0; unsigned l1 = 0u, l2 = 0u; float rstd = 0.f, w1 = 0.f, w2 = 0.f;
        if (router) {
            row = row0 + lane; const LAS float* lg = LG + lane * 48; const LAS float* lg2 = lg + 1024;
            rstd = 1.0f / sqrtf((LG[768 + lane] + LG[1024 + 768 + lane]) * (1.0f / D) + EPS);
            float gl[4];
#pragma unroll
            for (int i = 0; i < 4; ++i) gl[i] = (lg[i] + lg2[i]) * rstd + rgb[i];
            int gi = 0; float gm = gl[0];
#pragma unroll
            for (int i = 1; i < 4; ++i) if (gl[i] > gm) { gm = gl[i]; gi = i; }
            float gs = 0.f;
#pragma unroll
            for (int i = 0; i < 4; ++i) gs += __expf(gl[i] - gm);
            const float gwt = 1.0f / gs;
            float el[8];
#pragma unroll
            for (int j = 0; j < 8; ++j) { const float b0 = gi == 0 ? reb[j] : (gi == 1 ? reb[8 + j] : (gi == 2 ? reb[16 + j] : reb[24 + j])); el[j] = (lg[4 + gi * 8 + j] + lg2[4 + gi * 8 + j]) * rstd + b0; }
            int i1 = 0; float m1 = el[0];
#pragma unroll
            for (int j = 1; j < 8; ++j) if (el[j] > m1) { m1 = el[j]; i1 = j; }
            int i2 = -1; float m2 = -3.0e38f;
#pragma unroll
            for (int j = 0; j < 8; ++j) if (j != i1 && el[j] > m2) { m2 = el[j]; i2 = j; }
            const float ex = __expf(m2 - m1); w1 = gwt / (1.0f + ex); w2 = gwt * ex / (1.0f + ex);
            e1 = gi * 8 + i1; e2 = gi * 8 + i2;
            l1 = __hip_atomic_fetch_add((LAS unsigned*)(F.lds + MISC_OFF) + 640 + e1, 1u, __ATOMIC_RELAXED, __HIP_MEMORY_SCOPE_WORKGROUP);
            l2 = __hip_atomic_fetch_add((LAS unsigned*)(F.lds + MISC_OFF) + 640 + e2, 1u, __ATOMIC_RELAXED, __HIP_MEMORY_SCOPE_WORKGROUP);
        }
        __syncthreads();
        if (tid < 32) { const unsigned c = F.MISC[640 + tid]; F.MISC[672 + tid] = c ? __hip_atomic_fetch_add(cnt + tid * 64, c, __ATOMIC_RELAXED, __HIP_MEMORY_SCOPE_AGENT) : 0u; }
        __syncthreads();
        if (router) {
            const unsigned r1 = F.MISC[672 + e1] + l1, r2 = F.MISC[672 + e2] + l2;
            *(u32x2*)(toklist + 2 * ((size_t)e1 * LISTCAP + r1)) = (u32x2){(unsigned)row, __float_as_uint(rstd)}; *(u32x2*)(toklist + 2 * ((size_t)e2 * LISTCAP + r2)) = (u32x2){(unsigned)row, __float_as_uint(rstd)};
            *(u32x4*)(F.ws + WS_TOKINFO + (size_t)row * 32) = (u32x4){(unsigned)e1, r1, (unsigned)e2, r2}; *(f32x2*)(F.ws + WS_TOKINFO + (size_t)row * 32 + 16) = (f32x2){w1, w2};
        }
        __syncthreads();
    }
}

__device__ __forceinline__ void moe_table(const Frame& F, int l) {
    const int tid = F.tid;
    __syncthreads();
    if (tid < 64) {
        const unsigned c = tid < 32 ? __hip_atomic_load(F.ctl + CW_CNT + (l * 32 + tid) * 64, __ATOMIC_RELAXED, __HIP_MEMORY_SCOPE_AGENT) : 0u;
        const int nb = (int)((c + 255u) >> 8); int incl = nb;
#pragma unroll
        for (int d = 1; d < 32; d <<= 1) { const int t = __shfl_up(incl, d); if (tid >= d) incl += t; }
        const int excl = incl - nb;
        if (tid < 32) { F.MISC[64 + tid] = c; F.MISC[16 + tid] = (unsigned)excl;
            for (int b = 0; b < nb; ++b) { F.MISC[320 + excl + b] = ((int)c - b * 256 > 128) ? 1u : 0u; F.MISC[480 + excl + b] = (unsigned)tid; } }
        if (tid == 31) { F.MISC[16 + 32] = (unsigned)incl; F.MISC[127] = (unsigned)((incl + 7) >> 3); }
    }
    __syncthreads();
    const int R = (int)F.MISC[48], rc = (int)F.MISC[127];
    if (tid < R) { const int full = (int)F.MISC[320 + tid]; const int lo = (tid / rc) * rc, hi = (lo + rc) < R ? (lo + rc) : R; int nfull = 0, before = 0;
        for (int r = lo; r < hi; ++r) { const int f = (int)F.MISC[320 + r]; nfull += f; before += (r < tid) ? f : 0; }
        F.MISC[128 + (full ? lo + before : lo + nfull + (tid - lo - before))] = (unsigned)tid; }
    __syncthreads();
}


__global__ void __launch_bounds__(NWAVES * 64, 2) mk_fwd(Args args) {
    __shared__ __attribute__((aligned(16))) unsigned char lds_raw[LDS_BYTES];
    Frame F;
    F.lds = (LAS unsigned char*)lds_raw; F.MISC = (volatile LAS unsigned*)(F.lds + MISC_OFF);
    F.tid = 0; F.lane = 0; F.wave = __builtin_amdgcn_readfirstlane((int)threadIdx.x >> 6);
    F.G = gridDim.x; { const int bx = blockIdx.x; F.vcu = (F.G % 8 == 0) ? (bx % 8) * (F.G / 8) + bx / 8 : bx; }
    F.kp = (kptr_t)__builtin_amdgcn_kernarg_segment_ptr(); F.ws = arg_ws(F.kp); F.out = arg_out(F.kp); F.ctl = (unsigned*)(F.ws + WS_CTL);
    for (int u = (int)threadIdx.x; u < (LDS_BYTES - MISC_OFF) / 4; u += NWAVES * 64) ((LAS unsigned*)(F.lds + MISC_OFF))[u] = 0u;
    __syncthreads();
    XcdBarrier bar = xcd_barrier_post(F.ctl + CW_BAR, F.MISC);
#define GRID_BAR() do { XcdBarrier b2_; b2_.x = (unsigned)launder_s((int)bar.x); b2_.st = F.MISC; b2_.bar = (unsigned*)(arg_ws(launder_k(F.kp)) + WS_CTL) + CW_BAR; xcd_barrier(b2_); } while (0)
    if (P0_PROBE) { { Frame P; phase_frame(F, P); p0_prologue<P0_PROBE>(P); } GRID_BAR(); }
    for (int rep = 0; rep < REP_P0; ++rep) { { Frame P; phase_frame(F, P); p0_prologue<0>(P); }
    GRID_BAR(); }

#pragma unroll 1
    for (int l = 0; l < DEPTH; ++l) {
        for (int rep = 0; rep < REP_G1; ++rep) {
#define G1_BF16_PART() do { Frame P; phase_frame(F, P); unsigned char* ws = P.ws; \
                pg8::DenseOrder S; S.init(NTOK, g1split, 2 * D, P.G, (int)blockIdx.x, ws + WS_XN, (const bf16*)(ws + WS_WIN) + (size_t)l * DIN * D); \
                EpiInProj E{ws, arg_in(P.kp, I_BGATE) + (size_t)l * 2 * D, 0}; \
                pg8::gemm_phase<EpiInProj, pg8::DenseOrder, GM_G1, true, KREP_G1>(P.lds, P.tid, D, S, E); } while (0)
#define G1_FP8_PART() do { Frame P; phase_frame(F, P); unsigned char* ws = P.ws; \
                pg8::DenseOrder S; S.init(NTOK, DIN - g1split, D, P.G, (int)blockIdx.x, ws + WS_XN8, ws + WS_WIN8 + (size_t)l * 6144 * D); \
                EpiInProj E{ws, arg_in(P.kp, I_BGATE) + (size_t)l * 2 * D, g1split >> 8}; \
                pg8::gemm_phase<EpiInProj, pg8::DenseOrder, GM_G1, true, 1, true>(P.lds, P.tid, D, S, E); } while (0)
            const bool fp8_first = ((blockIdx.x >> 3) & 1) != 0; const int g1split = l >= G1_F8_FROM ? G1_SPLIT : 5120;
#pragma unroll 1
            for (int step = 0; step < 2; ++step) { if ((step == 0) == fp8_first) G1_FP8_PART(); else G1_BF16_PART(); }
        GRID_BAR(); }
        for (int rep = 0; rep < REP_MID; ++rep) { { Frame P; phase_frame(F, P); mid_phase(P, l); }
        GRID_BAR(); }
        for (int rep = 0; rep < REP_G2; ++rep) {
            Frame P; phase_frame(F, P); unsigned char* ws = P.ws;
            const bool f8 = l >= G2_F8_FROM;
            pg8::DenseOrder S; S.init(NTOK, D, f8 ? D : 2 * D, P.G, (int)blockIdx.x, ws + WS_YAB, (const bf16*)(ws + WS_WBR) + (size_t)l * D * D);
            EpiBranch E{ws, l >= G3_F8_FROM};
            if (f8) pg8::gemm_phase<EpiBranch, pg8::DenseOrder, GM_G2, true, 1, true>(P.lds, P.tid, D, S, E);
            else pg8::gemm_phase<EpiBranch, pg8::DenseOrder, GM_G2, true>(P.lds, P.tid, D, S, E);
        GRID_BAR(); }
        for (int rep = 0; rep < (l == 0 ? REP_G3L0 : 1); ++rep) {
            Frame P; phase_frame(F, P); unsigned char* ws = P.ws;
            const bool f8 = l >= G3_F8_FROM;
            pg8::DenseOrder S; S.init(NTOK, D, f8 ? D : 2 * D, P.G, (int)blockIdx.x, ws + WS_XN, (const bf16*)(ws + WS_WOUT) + (size_t)l * D * D);
            EpiOut E{ws};
            if (f8) pg8::gemm_phase<EpiOut, pg8::DenseOrder, GM_G3, true, 1, true>(P.lds, P.tid, D, S, E);
            else pg8::gemm_phase<EpiOut, pg8::DenseOrder, GM_G3, true, KREP_G3>(P.lds, P.tid, D, S, E);
        GRID_BAR(); }
        for (int rep = 0; rep < REP_R2; ++rep) { { Frame P; phase_frame(F, P); r2_phase(P, l, rep < REP_R2 - 1); }
        GRID_BAR(); }
        { Frame P; phase_frame(F, P); moe_table(P, l); }
        for (int rep = 0; rep < REP_G4; ++rep) {
            Frame P; phase_frame(F, P); unsigned char* ws = P.ws;
            pg8::MoeOrder<true> S; S.rbs = (const LAS int*)(P.lds + MISC_OFF + 64); S.cnt = (const LAS int*)(P.lds + MISC_OFF + 256); S.ord = (const LAS int*)(P.lds + MISC_OFF + 512); S.npn = 4; S.vcu = P.vcu; S.G = P.G; S.pitch = D;
            S.A = (const char*)(ws + WS_XN); S.Bt = (const char*)(ws + WS_WGU + (size_t)l * NE * 1024 * D); S.bstride = (size_t)1024 * D; S.toklist = (const unsigned*)(ws + WS_TOKLIST);
            EpiGU E{ws};
            pg8::gemm_phase<EpiGU, pg8::MoeOrder<true>, GM_G4, true, 1, true, false>(P.lds, P.tid, D, S, E);
        GRID_BAR(); }
        for (int rep = 0; rep < REP_G5; ++rep) {
            Frame P; phase_frame(F, P); unsigned char* ws = P.ws;
            pg8::MoeOrder<false> S; S.rbs = (const LAS int*)(P.lds + MISC_OFF + 64); S.cnt = (const LAS int*)(P.lds + MISC_OFF + 256); S.ord = (const LAS int*)(P.lds + MISC_OFF + 512); S.npn = 8; S.vcu = P.vcu; S.G = P.G; S.pitch = DE;
            S.A = (const char*)(ws + WS_HMID); S.Bt = (const char*)(ws + WS_WD + (size_t)l * NE * D * DE); S.bstride = (size_t)D * DE; S.toklist = nullptr;
            EpiDown E{ws, l >= YS_F8_FROM};
            pg8::gemm_phase<EpiDown, pg8::MoeOrder<false>, GM_G5, true, KREP_G5, true, false>(P.lds, P.tid, DE, S, E);
        GRID_BAR(); }
        for (int rep = 0; rep < REP_R1; ++rep) {
        if (l == 0) { { Frame P; phase_frame(F, P); row_pass<1>(P, arg_in(P.kp, I_N1G) + D); } GRID_BAR(); }
        else { { Frame P; phase_frame(F, P); row_pass<2>(P, arg_in(P.kp, I_FG)); } if (rep < REP_R1 - 1) GRID_BAR(); } }
    }
}

extern "C" void kernel_launch(void* const* d_in, const int* in_sizes, int n_in, void* d_out, int out_size, void* d_ws, size_t ws_size, hipStream_t stream) {
    static int grid = 0;
    if (grid == 0) {
        if (n_in != 20 || in_sizes[0] != NTOK * D || out_size != NTOK * D || ws_size < WS_END) { fprintf(stderr, "kernel_launch: unexpected shapes / workspace (%d inputs, ws %zu)\n", n_in, ws_size); grid = -1; return; }
        int dev = 0, cus = 0;
        if (hipGetDevice(&dev) != hipSuccess || hipDeviceGetAttribute(&cus, hipDeviceAttributeMultiprocessorCount, dev) != hipSuccess) { grid = -1; return; }
        grid = cus;
    }
    if (grid < 0) return;
    (void)hipMemsetAsync((char*)d_ws + WS_CTL, 0, CTL_ZERO_BYTES, stream);
    Args a{};
    for (int i = 0; i < 20; ++i) a.in[i] = (const float*)d_in[i];
    a.out = (float*)d_out; a.ws = (unsigned char*)d_ws;
    hipLaunchKernelGGL(mk_fwd, dim3(grid), dim3(NWAVES * 64), 0, stream, a);
}
```

```cpp
#include <hip/hip_runtime.h>
#include <cstdio>
#include <cstdint>

#ifndef GEMM_MODE
#define GEMM_MODE 2
#endif
#ifndef GM_G1
#define GM_G1 GEMM_MODE
#endif
#ifndef GM_G2
#define GM_G2 GEMM_MODE
#endif
#ifndef GM_G3
#define GM_G3 GEMM_MODE
#endif
#ifndef GM_G4
#define GM_G4 GEMM_MODE
#endif
#ifndef GM_G5
#define GM_G5 GEMM_MODE
#endif

#ifndef KREP_G1
#define KREP_G1 1
#endif
#ifndef KREP_G3
#define KREP_G3 1
#endif
#ifndef KREP_G5
#define KREP_G5 1
#endif
#ifndef NT_STORE
#define YS_F8_FROM 1
#define G1_F8_FROM 1
#define G1_SPLIT 3072
#define G2_F8_FROM 1
#define G3_F8_FROM 1
#define NT_STORE 0
#endif
#ifndef P0_PROBE
#define P0_PROBE 0
#endif
#ifndef ROUTER_SPLIT
#define ROUTER_SPLIT 0
#endif
#ifndef REP_R1
#define REP_R1 1
#endif
#ifndef REP_R2
#define REP_R2 1
#endif
#ifndef REP_P0
#define REP_P0 1
#endif
#ifndef REP_G1
#define REP_G1 1
#endif
#ifndef REP_MID
#define REP_MID 1
#endif
#ifndef REP_G2
#define REP_G2 1
#endif
#ifndef REP_G3L0
#define REP_G3L0 1
#endif
#ifndef REP_G4
#define REP_G4 1
#endif
#ifndef REP_G5
#define REP_G5 1
#endif
#define LAS __attribute__((address_space(3)))
#define GAS __attribute__((address_space(1)))
typedef unsigned short bf16;
typedef short bf16x8 __attribute__((ext_vector_type(8)));
typedef float f32x4 __attribute__((ext_vector_type(4)));
typedef float f32x2 __attribute__((ext_vector_type(2)));
typedef unsigned u32x4 __attribute__((ext_vector_type(4)));
typedef unsigned u32x2 __attribute__((ext_vector_type(2)));

constexpr int NTOK = 16384, D = 2048, DEPTH = 2, SEQ = 4096;
constexpr int CW = 1024;
constexpr int DIN = 9216;
constexpr int NE = 32, DE = 512, EPG = 8, NGRP = 4;
constexpr int CHUNK = 128, SG = 8;
constexpr int PROWS = 40960;
constexpr int LISTCAP = 16384;
constexpr float EPS = 1e-6f;
constexpr int NWAVES = 8;

constexpr size_t MiB = 1u << 20;
constexpr size_t WS_CTL = 0, CTL_ZERO_BYTES = 64 * 1024;
constexpr size_t WS_TOKINFO = 1 * MiB;
constexpr size_t WS_RT = 2 * MiB;
constexpr size_t WS_TOKLIST = 3 * MiB;
constexpr size_t WS_VSTAT = 1008 * MiB;
constexpr size_t WS_WIN = 8 * MiB;
constexpr size_t WS_WBR = 80 * MiB;
constexpr size_t WS_WOUT = 96 * MiB;
constexpr size_t WS_WGU = 112 * MiB;
constexpr size_t WS_WIN8 = 240 * MiB;
constexpr size_t WS_XN8 = 944 * MiB;
constexpr size_t WS_WD = 368 * MiB;
constexpr size_t WS_H1 = 560 * MiB;
constexpr size_t WS_H = 496 * MiB;
constexpr size_t WS_XN = 624 * MiB;
constexpr size_t WS_XC = 688 * MiB, WS_BB = 720 * MiB, WS_U = 752 * MiB, WS_V = 784 * MiB, WS_GR = 816 * MiB, WS_GB = 880 * MiB;
constexpr size_t WS_YSLOT = 688 * MiB;
constexpr size_t WS_YAB = 944 * MiB;
constexpr size_t WS_HMID = 944 * MiB;
constexpr size_t WS_DELTA = 880 * MiB;
constexpr size_t WS_END = 1010 * MiB;
constexpr int CW_TMO = 0;
constexpr int CW_BAR = 4096;
constexpr int CW_CNT = 8192;

constexpr int RING_BYTES = 131072;
constexpr int P0_SCR = 64 * 65 * 4;
constexpr int MISC_OFF = 8 * P0_SCR + 2048;
constexpr int LDS_BYTES = 147456;

#define LDS_WAIT() asm volatile("s_waitcnt lgkmcnt(0)" ::: "memory")
#define VM_WAIT() asm volatile("s_waitcnt vmcnt(0)" ::: "memory")

__device__ __forceinline__ unsigned cvt_pk_bf16(float lo, float hi) { unsigned r; asm volatile("v_cvt_pk_bf16_f32 %0, %1, %2" : "=v"(r) : "v"(lo), "v"(hi)); return r; }
__device__ __forceinline__ unsigned pk4_fp8(float a, float b, float c, float d) { int w = 0; w = __builtin_amdgcn_cvt_pk_fp8_f32(a, b, w, false); w = __builtin_amdgcn_cvt_pk_fp8_f32(c, d, w, true); return (unsigned)w; }
__device__ __forceinline__ float bflo(unsigned w) { return __uint_as_float(w << 16); }
__device__ __forceinline__ float bfhi(unsigned w) { return __uint_as_float(w & 0xffff0000u); }
__device__ __forceinline__ float fast_sigmoid(float x) { return __builtin_amdgcn_rcpf(1.0f + __builtin_amdgcn_exp2f(-1.44269504f * x)); }
__device__ __forceinline__ float gelu_tanh(float x) { const float y = 0.7978845608f * (x + 0.044715f * x * x * x); return x * fast_sigmoid(2.0f * y); }
__device__ __forceinline__ f32x4 gelu_tanh4(const f32x4 x) {
    const float C1 = -2.0f * 0.7978845608f * 1.44269504f, C3 = C1 * 0.044715f;
    const f32x4 z = x * ((x * x) * C3 + C1); f32x4 t;
#pragma unroll
    for (int j = 0; j < 4; ++j) t[j] = __builtin_amdgcn_exp2f(z[j]);
    t = t + 1.0f;
#pragma unroll
    for (int j = 0; j < 4; ++j) t[j] = __builtin_amdgcn_rcpf(t[j]);
    return x * t;
}
__device__ __forceinline__ float wave_sum(float v) {
    int x = __float_as_int(v);
    v += __int_as_float(__builtin_amdgcn_update_dpp(0, x, 0xB1, 0xF, 0xF, true));  x = __float_as_int(v);
    v += __int_as_float(__builtin_amdgcn_update_dpp(0, x, 0x4E, 0xF, 0xF, true));  x = __float_as_int(v);
    v += __int_as_float(__builtin_amdgcn_update_dpp(0, x, 0x141, 0xF, 0xF, true)); x = __float_as_int(v);
    v += __int_as_float(__builtin_amdgcn_update_dpp(0, x, 0x140, 0xF, 0xF, true)); x = __float_as_int(v);
    return (__int_as_float(__builtin_amdgcn_readlane(x, 0)) + __int_as_float(__builtin_amdgcn_readlane(x, 16))) + (__int_as_float(__builtin_amdgcn_readlane(x, 32)) + __int_as_float(__builtin_amdgcn_readlane(x, 48)));
}

#define XB_TMO      128
#define XB_XCNT(j)  (256  + 64 * (j))
#define XB_XSUB(j)  (1280 + 64 * (j))
#define XB_XGEN(j)  (2304 + 64 * (j))
#define XB_TOP      3328
#define XB_TOPGEN   3392
#define XCD_BAR_WORDS 3456
#define XB_SPIN_CAP (1u << 18)
__device__ __forceinline__ unsigned xb_ld(unsigned* p)              { return __hip_atomic_load(p, __ATOMIC_RELAXED, __HIP_MEMORY_SCOPE_AGENT); }
__device__ __forceinline__ unsigned xb_add(unsigned* p, unsigned v) { return __hip_atomic_fetch_add(p, v, __ATOMIC_RELAXED, __HIP_MEMORY_SCOPE_AGENT); }
__device__ __forceinline__ unsigned xb_xcc_id() { return (unsigned)__builtin_amdgcn_s_getreg((3 << 11) | 20) & 0xFu; }
#define XB_SPIN(cond, bar) do { unsigned _sp = 0; while (cond) { __builtin_amdgcn_s_sleep(1); \
    if ((++_sp & 255u) == 0u) { if (xb_ld(&(bar)[XB_TMO])) break; if (_sp > XB_SPIN_CAP) { atomicAdd(&(bar)[XB_TMO], 1u); break; } } } } while (0)
struct XcdBarrier { unsigned* bar; unsigned x; volatile LAS unsigned* st; };
__device__ __forceinline__ XcdBarrier xcd_barrier_post(unsigned* bar, volatile LAS unsigned* st) {
    XcdBarrier b; b.bar = bar; b.x = xb_xcc_id(); b.st = st;
    if (threadIdx.x == 0) (void)xb_add(&bar[XB_XCNT(b.x)], 1u);
    return b;
}
__device__ __forceinline__ void xcd_barrier_complete(unsigned* bar, unsigned x, unsigned& nloc, unsigned& nx) {
    const unsigned G = gridDim.x * gridDim.y * gridDim.z;
    unsigned sum, cnt, mine, sp = 0u;
    for (;;) {
        sum = 0u; cnt = 0u; mine = 0u;
#pragma unroll
        for (unsigned j = 0; j < 16; ++j) { const unsigned c = xb_ld(&bar[XB_XCNT(j)]); sum += c; cnt += (c > 0u) ? 1u : 0u; mine = (j == x) ? c : mine; }
        if (sum == G) break;
        __builtin_amdgcn_s_sleep(1);
        if ((++sp & 255u) == 0u) { if (xb_ld(&bar[XB_TMO])) break; if (sp > XB_SPIN_CAP) { atomicAdd(&bar[XB_TMO], 1u); break; } }
    }
    nloc = mine > 0u ? mine : 1u; nx = cnt > 0u ? cnt : 1u;
}
__device__ __forceinline__ void xcd_barrier(const XcdBarrier& b) {
    asm volatile("s_waitcnt vmcnt(0)" ::: "memory");
    __syncthreads();
    if (threadIdx.x == 0) {
        unsigned* bar = b.bar;
        __builtin_amdgcn_s_waitcnt(0);
        unsigned nloc = b.st[0], nx = b.st[1];
        if (nloc == 0u) { xcd_barrier_complete(bar, b.x, nloc, nx); b.st[0] = nloc; b.st[1] = nx; }
        const unsigned old = xb_add(&bar[XB_XSUB(b.x)], 1u);
        const unsigned gen = old / nloc;
        if (old + 1u == (gen + 1u) * nloc) {
            __builtin_amdgcn_fence(__ATOMIC_RELEASE, "agent");
            asm volatile("s_waitcnt vmcnt(0)" ::: "memory");
            const unsigned og = xb_add(&bar[XB_TOP], 1u);
            const unsigned tg = og / nx;
            if (og + 1u == (tg + 1u) * nx) xb_add(&bar[XB_TOPGEN], 1u);
            else XB_SPIN(xb_ld(&bar[XB_TOPGEN]) == tg, bar);
            __builtin_amdgcn_fence(__ATOMIC_ACQUIRE, "agent");
            xb_add(&bar[XB_XGEN(b.x)], 1u);
            asm volatile("s_waitcnt vmcnt(0)" ::: "memory");
        } else {
            XB_SPIN(xb_ld(&bar[XB_XGEN(b.x)]) == gen, bar);
            __builtin_amdgcn_fence(__ATOMIC_ACQUIRE, "agent");
            asm volatile("s_waitcnt vmcnt(0)" ::: "memory");
        }
    }
    __syncthreads();
}

__device__ __forceinline__ int fresh_lane() { int ln; asm volatile("v_mbcnt_lo_u32_b32 %0, -1, 0\n\tv_mbcnt_hi_u32_b32 %0, -1, %0" : "=&v"(ln)); return ln; }
namespace pg8 {
constexpr int BM = 256, BK = 64, HALF = 128, HTB = HALF * BK * 2, STAGE_BYTES = 8 * HTB, NXCD = 8, WGM = 8;
__host__ __device__ __forceinline__ int lds_byte(int r, int c) { const int st = (r >> 4) * 2 + (c >> 5), rr = r & 15, cc = c & 31, ob = rr * 64 + cc * 2; return st * 1024 + (ob ^ (((ob >> 9) & 1) << 5)); }
__host__ __device__ __forceinline__ void stage_rc(int b, int& R, int& C) { const int st = b / 1024, sb = b % 1024, swz = sb ^ (((sb >> 9) & 1) << 5); R = (st >> 1) * 16 + swz / 64; C = (st & 1) * 32 + (swz % 64) / 2; }
__host__ __device__ __forceinline__ int perm32(int rho) { const int n = rho >> 4, i = rho & 15; return 8 * (i >> 2) + 4 * n + (i & 3); }

struct Unit { int pm, pn, e, rbl, nvalid; };

struct DenseOrder {
    static constexpr bool AOFF_LOADS = false;
    int nM, nN, nwg, G, c, pitch; const char* A; const char* Bt;
    __device__ void init(int M, int N, int pitch_, int G_, int c_, const void* A_, const void* Bt_) { nM = M / BM; nN = N / BM; nwg = nM * nN; G = G_; c = c_; pitch = pitch_; A = (const char*)A_; Bt = (const char*)Bt_; }
    __device__ __forceinline__ bool next(int i, Unit& u) const {
        const long L = (long)i * G + c; if (L >= nwg) return false;
        int wgid = (int)L; { const int q = nwg / NXCD, r = nwg % NXCD, xcd = wgid % NXCD, off = wgid / NXCD; wgid = (xcd < r ? xcd * (q + 1) : r * (q + 1) + (xcd - r) * q) + off; }
        const int nig = WGM * nN, gid = wgid / nig, fm = gid * WGM, gsz = (nM - fm) < WGM ? (nM - fm) : WGM;
        u.pm = fm + ((wgid % nig) % gsz); u.pn = (wgid % nig) / gsz; u.e = 0; u.rbl = 0; u.nvalid = 256; return true;
    }
    __device__ __forceinline__ const char* a_base(const Unit& u) const { return A + (size_t)u.pm * BM * pitch; }
    __device__ __forceinline__ const char* b_base(const Unit& u) const { return Bt + (size_t)u.pn * BM * pitch; }
    __device__ __forceinline__ unsigned a_row_off(const Unit&, int r) const { return (unsigned)(r * pitch); }
};

template <bool GATHER> struct MoeOrder {
    static constexpr bool AOFF_LOADS = GATHER;
    const LAS int* rbs; const LAS int* cnt; const LAS int* ord; int npn, vcu, G, pitch;
    const char* A; const char* Bt; size_t bstride; const unsigned* toklist;
    __device__ __forceinline__ bool next(int i, Unit& u) const {
        const int R = rbs[32], rc = ord[-1], gp = G >> 3, x = vcu / gp, j = i * gp + (vcu % gp);
        const int rbi = j / npn, lo = x * rc, nloc = (lo + rc < R ? lo + rc : R) - lo;
        if (rbi >= nloc) return false;
        const int L = j, rb = ord[lo + rbi]; const int e = ord[352 + rb];
        u.pm = rb; u.pn = L - rbi * npn; u.e = e; u.rbl = rb - rbs[e];
        const int left = cnt[e] - u.rbl * 256; u.nvalid = left < 256 ? left : 256; return true;
    }
    __device__ __forceinline__ const char* a_base(const Unit& u) const { return GATHER ? A : A + (size_t)u.pm * BM * pitch; }
    __device__ __forceinline__ const char* b_base(const Unit& u) const { return Bt + (size_t)u.e * bstride + (size_t)u.pn * BM * pitch; }
    __device__ __forceinline__ unsigned a_row_off(const Unit& u, int r) const {
        if (!GATHER) return (unsigned)(r * pitch);
        const int rc = r < u.nvalid ? r : u.nvalid - 1;
        const unsigned tok = toklist[2 * (unsigned)(u.e * LISTCAP + u.rbl * 256 + rc)];
        return tok * (unsigned)pitch;
    }
};

typedef int i32x4 __attribute__((ext_vector_type(4)));
typedef int i32x8 __attribute__((ext_vector_type(8)));
__device__ __forceinline__ i32x8 cat16(const bf16x8 a, const bf16x8 b) { return __builtin_shufflevector(__builtin_bit_cast(i32x4, a), __builtin_bit_cast(i32x4, b), 0, 1, 2, 3, 4, 5, 6, 7); }
template <class Epi, class Sched, int MODE, bool ALIGN_EPI, int KREP = 1, bool F8 = false, bool LIGHT = false>
__device__ __forceinline__ void gemm_phase(LAS unsigned char* lds, const int tid, const int K, const Sched& S, const Epi& E) {
    const int wid = __builtin_amdgcn_readfirstlane(tid >> 6), lane = tid & 63, wr = wid >> 2, wc = wid & 3, fr = lane & 15, fq = lane >> 4;
    if constexpr (MODE == 9) return;
    const int nt = F8 ? K / 128 : K / BK, pitch = F8 ? K : 2 * K;
    static_assert(!(F8 && MODE == 0), "direct mode is bf16 only");
    f32x4 acc[2][2][4][2];
#define PG8_ZERO_ACC() do { _Pragma("unroll") for (int a = 0; a < 2; ++a) _Pragma("unroll") for (int b = 0; b < 2; ++b) _Pragma("unroll") for (int m = 0; m < 4; ++m) _Pragma("unroll") for (int n = 0; n < 2; ++n) acc[a][b][m][n] = (f32x4){0.f, 0.f, 0.f, 0.f}; } while (0)
    if constexpr (MODE == 0) {
        Unit cur;
#pragma unroll 1
        for (int ui = 0; S.next(ui, cur); ++ui) {
            PG8_ZERO_ACC();
            const char* Ab = S.a_base(cur); const char* Bb = S.b_base(cur);
            unsigned ao[2][4], bo[2][2];
#pragma unroll
            for (int ai = 0; ai < 2; ++ai)
#pragma unroll
                for (int m = 0; m < 4; ++m) ao[ai][m] = S.a_row_off(cur, ai * HALF + wr * 64 + m * 16 + fr) + (unsigned)(fq * 16);
#pragma unroll
            for (int bj = 0; bj < 2; ++bj)
#pragma unroll
                for (int n = 0; n < 2; ++n) { const int rho = n * 16 + fr, brow = bj * HALF + wc * 32 + (Epi::PERM ? perm32(rho) : rho); bo[bj][n] = (unsigned)(brow * pitch + fq * 16); }
#pragma unroll 1
            for (int t2 = 0; t2 < 2 * nt; ++t2) {
                if constexpr (Epi::MID) { if (t2 == nt) { const int ln_ = fresh_lane(); E.mid(acc, cur, wr, wc, ln_ & 15, ln_ >> 4); } }
                {
                    bf16x8 Af[2][4], Bf[2][2];
                    const unsigned ko = (unsigned)(t2 * 64);
#pragma unroll
                    for (int ai = 0; ai < 2; ++ai)
#pragma unroll
                        for (int m = 0; m < 4; ++m) Af[ai][m] = *(const bf16x8*)(Ab + ao[ai][m] + ko);
#pragma unroll
                    for (int bj = 0; bj < 2; ++bj)
#pragma unroll
                        for (int n = 0; n < 2; ++n) Bf[bj][n] = *(const bf16x8*)(Bb + bo[bj][n] + ko);
#pragma unroll
                    for (int ai = 0; ai < 2; ++ai)
#pragma unroll
                        for (int bj = 0; bj < 2; ++bj)
#pragma unroll
                            for (int m = 0; m < 4; ++m)
#pragma unroll
                                for (int n = 0; n < 2; ++n) acc[ai][bj][m][n] = __builtin_amdgcn_mfma_f32_16x16x32_bf16(Bf[bj][n], Af[ai][m], acc[ai][bj][m][n], 0, 0, 0);
                }
            }
            { const int ln_ = fresh_lane(); E(acc, cur, wr, wc, ln_ & 15, ln_ >> 4); }
        }
    } else {
        int Rr[2], Cc[2]; unsigned voffB[2];
#pragma unroll
        for (int i = 0; i < 2; ++i) { stage_rc(tid * 16 + i * 8192, Rr[i], Cc[i]); const int Rb = Epi::PERM ? ((Rr[i] & ~31) + perm32(Rr[i] & 31)) : Rr[i]; voffB[i] = (unsigned)(Rb * pitch + Cc[i] * 2); }
        const size_t kstep = (size_t)(BK * 2);
        const size_t hstep = (size_t)HALF * pitch;
        const unsigned ldsw = (unsigned)wid * 1024u;
        const int aoff = lds_byte(wr * 64 + fr, fq * 8), boff = lds_byte(wc * 32 + fr, fq * 8);
#define PG8_SA(b, h) (((b) * 2 + (h)) * HTB)
#define PG8_SB(b, h) ((4 + (b) * 2 + (h)) * HTB)
#define PG8_STAGE(bufoff, gbase, voff) do { _Pragma("unroll") for (int _i = 0; _i < 2; ++_i) \
        __builtin_amdgcn_global_load_lds((const unsigned*)((const char*)(gbase) + (voff)[_i]), (LAS unsigned*)(lds + (bufoff) + ldsw + _i * 8192), 16, 0, 0); } while (0)
#define PG8_LDA(dst, b, h) do { if constexpr (F8) { _Pragma("unroll") for (int m = 0; m < 4; ++m) { dst##8[m].lo = *(const LAS i32x4*)(lds + PG8_SA(b, h) + aoff + m * 2048); dst##8[m].hi = *(const LAS i32x4*)(lds + PG8_SA(b, h) + aoff + m * 2048 + 1024); } } \
        else { _Pragma("unroll") for (int m = 0; m < 4; ++m) _Pragma("unroll") for (int k = 0; k < 2; ++k) dst[m][k] = *(const LAS bf16x8*)(lds + PG8_SA(b, h) + aoff + m * 2048 + k * 1024); } } while (0)
#define PG8_LDB(dst, b, h) do { if constexpr (F8) { _Pragma("unroll") for (int n = 0; n < 2; ++n) { dst##8[n].lo = *(const LAS i32x4*)(lds + PG8_SB(b, h) + boff + n * 2048); dst##8[n].hi = *(const LAS i32x4*)(lds + PG8_SB(b, h) + boff + n * 2048 + 1024); } } \
        else { _Pragma("unroll") for (int n = 0; n < 2; ++n) _Pragma("unroll") for (int k = 0; k < 2; ++k) dst[n][k] = *(const LAS bf16x8*)(lds + PG8_SB(b, h) + boff + n * 2048 + k * 1024); } } while (0)
#define PG8_MMA(ai, bj, At, Bt) do { __builtin_amdgcn_s_setprio(1); \
        if constexpr (F8) { _Pragma("unroll") for (int m = 0; m < 4; ++m) _Pragma("unroll") for (int n = 0; n < 2; ++n) \
            asm volatile("s_nop 1\n\tv_mfma_scale_f32_16x16x128_f8f6f4 %0, %1, %2, %0, %3, %4 op_sel_hi:[0,0,0]" : "+v"(acc[ai][bj][m][n]) : "v"(Bt##8[n]), "v"(At##8[m]), "v"(sc_w), "v"(sc_x)); } \
        else { _Pragma("unroll") for (int m = 0; m < 4; ++m) _Pragma("unroll") for (int n = 0; n < 2; ++n) _Pragma("unroll") for (int k = 0; k < 2; ++k) \
            acc[ai][bj][m][n] = __builtin_amdgcn_mfma_f32_16x16x32_bf16(Bt[n][k], At[m][k], acc[ai][bj][m][n], 0, 0, 0); } \
        __builtin_amdgcn_s_setprio(0); } while (0)
#define PG8_WAIT_V(n) asm volatile("s_waitcnt vmcnt(" #n ")" ::: "memory")
#define PG8_WAIT_L(n) asm volatile("s_waitcnt lgkmcnt(" #n ")" ::: "memory")
#define PG8_BAR __builtin_amdgcn_s_barrier()
#define PG8_SCHED __builtin_amdgcn_sched_barrier(0)
#define PG8_AOFFS(dst, u) do { _Pragma("unroll") for (int _h = 0; _h < 2; ++_h) _Pragma("unroll") for (int _i = 0; _i < 2; ++_i) dst[_h][_i] = S.a_row_off(u, _h * HALF + Rr[_i]) + (unsigned)(Cc[_i] * 2); } while (0)
        constexpr bool SP2 = (MODE == 2);
        const int sc_w = 122, sc_x = 127;
        Unit cur, nxt; int ui = 0;
        if (!S.next(0, cur)) return;
        PG8_ZERO_ACC();
        bf16x8 At[4][2], B0[2][2], B1[2][2]; i32x8 At8[4], B08[2], B18[2];
        const char* cA = S.a_base(cur); const char* cB = S.b_base(cur);
        unsigned cO[2][2], nO[2][2];
        PG8_AOFFS(cO, cur);
#pragma unroll
        for (int _h = 0; _h < 2; ++_h)
#pragma unroll
            for (int _i = 0; _i < 2; ++_i) nO[_h][_i] = cO[_h][_i];
        if constexpr (SP2) {
            PG8_STAGE(PG8_SB(0, 0), cB, voffB); PG8_STAGE(PG8_SB(0, 1), cB + hstep, voffB); PG8_STAGE(PG8_SA(0, 0), cA, cO[0]); PG8_STAGE(PG8_SA(0, 1), cA, cO[1]);
            if (wr == 1) PG8_BAR;
            PG8_WAIT_V(2); PG8_BAR;
            PG8_STAGE(PG8_SB(1, 0), cB + kstep, voffB); PG8_STAGE(PG8_SA(1, 0), cA + kstep, cO[0]); PG8_STAGE(PG8_SB(1, 1), cB + hstep + kstep, voffB);
            PG8_WAIT_V(6); PG8_BAR;
        } else {
            PG8_STAGE(PG8_SB(0, 0), cB, voffB); PG8_STAGE(PG8_SA(0, 0), cA, cO[0]); PG8_STAGE(PG8_SB(0, 1), cB + hstep, voffB); PG8_STAGE(PG8_SA(0, 1), cA, cO[1]);
            if (wr == 1) PG8_BAR;
            PG8_WAIT_V(4); PG8_BAR;
            PG8_STAGE(PG8_SB(1, 0), cB + kstep, voffB); PG8_STAGE(PG8_SA(1, 0), cA + kstep, cO[0]); PG8_STAGE(PG8_SB(1, 1), cB + hstep + kstep, voffB);
            PG8_WAIT_V(6); PG8_BAR;
        }
        for (;;) {
            const bool has_next = S.next(ui + 1, nxt);
            const bool lightu = LIGHT && cur.nvalid <= 128;
            const char* nA = has_next ? S.a_base(nxt) : cA; const char* nB = has_next ? S.b_base(nxt) : cB;
            if constexpr (!Sched::AOFF_LOADS) { if (has_next) PG8_AOFFS(nO, nxt); }
#pragma unroll 1
            for (int rep = 0; rep < KREP; ++rep)
#pragma unroll 1
            for (int t = 0; t < nt; t += 2) {
                const bool last = (t == nt - 2), lastrep = (rep == KREP - 1), sw = last && lastrep && has_next;
                if constexpr (Epi::MID) { if (t == nt / 2) { if constexpr (F8) asm volatile("s_nop 15\n\ts_nop 3" ::: "memory"); const int ln_ = fresh_lane(); E.mid(acc, cur, wr, wc, ln_ & 15, ln_ >> 4); } }
                if constexpr (Sched::AOFF_LOADS) if (t == 0 && rep == 0 && has_next) PG8_AOFFS(nO, nxt);
                const char* a1 = cA + (size_t)(t + 1) * kstep;
                const char* a2 = last ? (lastrep ? nA : cA) : cA + (size_t)(t + 2) * kstep; const char* b2 = last ? (lastrep ? nB : cB) : cB + (size_t)(t + 2) * kstep;
                const char* a3 = a2 + kstep; const char* b3 = b2 + kstep;
                unsigned o2[2][2];
#pragma unroll
                for (int _h = 0; _h < 2; ++_h)
#pragma unroll
                    for (int _i = 0; _i < 2; ++_i) o2[_h][_i] = sw ? nO[_h][_i] : cO[_h][_i];
                if constexpr (SP2) {
                    PG8_LDB(B0, 0, 0); PG8_LDB(B1, 0, 1); PG8_SCHED; PG8_LDA(At, 0, 0); PG8_STAGE(PG8_SA(1, 1), a1, cO[1]);
                    PG8_WAIT_V(8); PG8_WAIT_L(0); PG8_BAR; PG8_MMA(0, 0, At, B0); PG8_MMA(0, 1, At, B1); PG8_BAR; PG8_SCHED;
                    if (!lightu) PG8_LDA(At, 0, 1); PG8_STAGE(PG8_SB(0, 0), b2, voffB); PG8_STAGE(PG8_SB(0, 1), b2 + hstep, voffB); PG8_STAGE(PG8_SA(0, 0), a2, o2[0]);
                    PG8_WAIT_V(8); PG8_WAIT_L(0); PG8_BAR; if (!lightu) { PG8_MMA(1, 0, At, B0); PG8_MMA(1, 1, At, B1); } PG8_BAR; PG8_SCHED;
                    PG8_LDB(B0, 1, 0); PG8_LDB(B1, 1, 1); PG8_SCHED; PG8_LDA(At, 1, 0); PG8_STAGE(PG8_SA(0, 1), a2, o2[1]);
                    PG8_WAIT_V(8); PG8_WAIT_L(0); PG8_BAR; PG8_MMA(0, 0, At, B0); PG8_MMA(0, 1, At, B1); PG8_BAR; PG8_SCHED;
                    if (!lightu) PG8_LDA(At, 1, 1); PG8_STAGE(PG8_SB(1, 0), b3, voffB); PG8_STAGE(PG8_SB(1, 1), b3 + hstep, voffB); PG8_STAGE(PG8_SA(1, 0), a3, o2[0]);
                    PG8_WAIT_V(8); PG8_WAIT_L(0); PG8_BAR; if (!lightu) { PG8_MMA(1, 0, At, B0); PG8_MMA(1, 1, At, B1); } PG8_BAR; PG8_SCHED;
                } else {
                    PG8_LDB(B0, 0, 0); PG8_SCHED; PG8_LDA(At, 0, 0); PG8_STAGE(PG8_SA(1, 1), a1, cO[1]);
                    PG8_WAIT_L(8); PG8_BAR; PG8_WAIT_L(0); PG8_MMA(0, 0, At, B0); PG8_BAR; PG8_SCHED;
                    PG8_LDB(B1, 0, 1); PG8_STAGE(PG8_SB(0, 0), b2, voffB);
                    PG8_BAR; PG8_WAIT_L(0); PG8_MMA(0, 1, At, B1); PG8_BAR;
                    PG8_LDA(At, 0, 1); PG8_STAGE(PG8_SA(0, 0), a2, o2[0]);
                    PG8_BAR; PG8_WAIT_L(0); PG8_MMA(1, 0, At, B0); PG8_BAR; PG8_SCHED;
                    PG8_STAGE(PG8_SB(0, 1), b2 + hstep, voffB);
                    PG8_WAIT_V(6); PG8_BAR; PG8_MMA(1, 1, At, B1); PG8_BAR;
                    PG8_LDB(B0, 1, 0); PG8_SCHED; PG8_LDA(At, 1, 0); PG8_STAGE(PG8_SA(0, 1), a2, o2[1]);
                    PG8_WAIT_L(8); PG8_BAR; PG8_WAIT_L(0); PG8_MMA(0, 0, At, B0); PG8_BAR; PG8_SCHED;
                    PG8_LDB(B1, 1, 1); PG8_STAGE(PG8_SB(1, 0), b3, voffB);
                    PG8_BAR; PG8_WAIT_L(0); PG8_MMA(0, 1, At, B1); PG8_BAR;
                    PG8_LDA(At, 1, 1); PG8_STAGE(PG8_SA(1, 0), a3, o2[0]);
                    PG8_BAR; PG8_WAIT_L(0); PG8_MMA(1, 0, At, B0); PG8_BAR; PG8_SCHED;
                    PG8_STAGE(PG8_SB(1, 1), b3 + hstep, voffB);
                    PG8_WAIT_V(6); PG8_BAR; PG8_MMA(1, 1, At, B1); PG8_BAR;
                }
            }
            if constexpr (ALIGN_EPI) { if (wr == 0) PG8_BAR; }
            if constexpr (F8) asm volatile("s_nop 15\n\ts_nop 3" ::: "memory");
            if constexpr (KREP > 1) { _Pragma("unroll") for (int a = 0; a < 2; ++a) _Pragma("unroll") for (int b = 0; b < 2; ++b) _Pragma("unroll") for (int m = 0; m < 4; ++m) _Pragma("unroll") for (int n = 0; n < 2; ++n) acc[a][b][m][n] *= (1.0f / KREP); }
            { const int ln_ = fresh_lane(); E(acc, cur, wr, wc, ln_ & 15, ln_ >> 4); }
            if (!has_next) break;
            PG8_ZERO_ACC();
            cur = nxt; cA = nA; cB = nB; ++ui;
#pragma unroll
            for (int _h = 0; _h < 2; ++_h)
#pragma unroll
                for (int _i = 0; _i < 2; ++_i) cO[_h][_i] = nO[_h][_i];
            if constexpr (ALIGN_EPI) { if (wr == 1) PG8_BAR; }
        }
        PG8_WAIT_V(0);
        if constexpr (!ALIGN_EPI) { if (wr == 0) PG8_BAR; }
        PG8_BAR;
#undef PG8_SA
#undef PG8_SB
#undef PG8_STAGE
#undef PG8_LDA
#undef PG8_LDB
#undef PG8_MMA
#undef PG8_WAIT_V
#undef PG8_WAIT_L
#undef PG8_BAR
#undef PG8_SCHED
#undef PG8_AOFFS
    }
#undef PG8_ZERO_ACC
}
}

using pg8::Unit;
typedef f32x4 AccT[2][2][4][2];
__device__ __forceinline__ int launder_v(int x) { asm volatile("" : "+v"(x)); return x; }
__device__ __forceinline__ u32x4 pack8(const f32x4 a, const f32x4 b) { u32x4 w; w.x = cvt_pk_bf16(a[0], a[1]); w.y = cvt_pk_bf16(a[2], a[3]); w.z = cvt_pk_bf16(b[0], b[1]); w.w = cvt_pk_bf16(b[2], b[3]); return w; }
__device__ __forceinline__ void st16(char* p, const u32x4 v) { if (NT_STORE) __builtin_nontemporal_store(v, (u32x4*)p); else *(u32x4*)p = v; }
__device__ __forceinline__ f32x4 unlo(const u32x4 g) { return (f32x4){bflo(g.x), bfhi(g.x), bflo(g.y), bfhi(g.y)}; }
__device__ __forceinline__ f32x4 unhi(const u32x4 g) { return (f32x4){bflo(g.z), bfhi(g.z), bflo(g.w), bfhi(g.w)}; }

struct EpiInProj {
    static constexpr bool PERM = true, MID = false;
    unsigned char* ws; const float* bgate; int pn0; const LAS unsigned char* bl;
    __device__ __forceinline__ void mid(AccT&, const Unit&, int, int, int, int) const {}
    __device__ __forceinline__ void operator()(const AccT& acc, const Unit& u, int wr, int wc, int fr, int fq) const {
        const int row0 = launder_v(u.pm * 256 + wr * 64 + fr), pn = u.pn + pn0, cl = wc * 32 + 8 * fq;
        if (pn < 8) {
            char* XC = (char*)(ws + WS_XC); const unsigned o0 = ((unsigned)row0 * CW + pn * 128 + cl) * 2u;
#pragma unroll
            for (int ai = 0; ai < 2; ++ai)
#pragma unroll
                for (int m = 0; m < 4; ++m)
                    st16(XC + o0 + (unsigned)((ai * 128 + m * 16) * CW * 2), pack8(acc[ai][0][m][0] * acc[ai][1][m][0], acc[ai][0][m][1] * acc[ai][1][m][1]));
        } else if (pn < 20) {
            const int kind = (pn - 8) >> 2, q = (pn - 8) & 3;
            char* dst = (char*)(ws + (kind == 0 ? WS_BB : (kind == 1 ? WS_U : WS_V))); const unsigned o0 = ((unsigned)row0 * CW + q * 256 + cl) * 2u;
            char* VST = (char*)(ws + WS_VSTAT); const unsigned so = ((unsigned)row0 * 16 + q * 4 + wc) * 8u;
#pragma unroll
            for (int ai = 0; ai < 2; ++ai)
#pragma unroll
                for (int m = 0; m < 4; ++m) { float s = 0.f, sq = 0.f;
#pragma unroll
                    for (int bj = 0; bj < 2; ++bj) { f32x4 v0 = acc[ai][bj][m][0], v1 = acc[ai][bj][m][1];
                        if (kind != 0) { v0 = gelu_tanh4(v0); v1 = gelu_tanh4(v1); }
                        if (kind == 2) {
#pragma unroll
                            for (int j = 0; j < 4; ++j) { s += v0[j] + v1[j]; sq += v0[j] * v0[j] + v1[j] * v1[j]; } }
                        st16(dst + o0 + (unsigned)(((ai * 128 + m * 16) * CW + bj * 128) * 2), pack8(v0, v1)); }
                    if (kind == 2) { s += __shfl_xor(s, 16); s += __shfl_xor(s, 32); sq += __shfl_xor(sq, 16); sq += __shfl_xor(sq, 32);
                        if (fq == 0) *(f32x2*)(VST + so + (unsigned)((ai * 128 + m * 16) * 16 * 8)) = (f32x2){s, sq}; }
                    asm volatile("" ::: "memory"); }
        } else {
            const int d0 = (pn - 20) * 128 + cl;
            char* GR = (char*)(ws + WS_GR); char* GB = (char*)(ws + WS_GB); const unsigned o0 = ((unsigned)((u.pm * 16 + (pn - 20)) * 8 + wr * 4 + wc) * 8u) * 1024u + (unsigned)launder_v(fq * 16 + fr) * 16u;
            f32x4 ba[2], bb[2]; const float NL2E = -1.44269504f, CL = 43.2808512f;
#pragma unroll
            for (int n = 0; n < 2; ++n) {
                const u32x2 pa = *(const LAS u32x2*)(bl + (d0 + 4 * n) * 2), pb = *(const LAS u32x2*)(bl + (D + d0 + 4 * n) * 2);
                ba[n] = (f32x4){bflo(pa.x), bfhi(pa.x), bflo(pa.y), bfhi(pa.y)}; bb[n] = (f32x4){bflo(pb.x), bfhi(pb.x), bflo(pb.y), bfhi(pb.y)}; }
#pragma unroll
            for (int ai = 0; ai < 2; ++ai)
#pragma unroll
                for (int m = 0; m < 4; ++m) { f32x4 r[2], sb[2];
#pragma unroll
                    for (int n = 0; n < 2; ++n) {
                        f32x4 xa = acc[ai][0][m][n] * NL2E + ba[n], xb = acc[ai][1][m][n] * NL2E + bb[n], ta, tb;
#pragma unroll
                        for (int j = 0; j < 4; ++j) { ta[j] = __builtin_amdgcn_exp2f(__builtin_amdgcn_fmed3f(xa[j], -CL, CL)); tb[j] = __builtin_amdgcn_exp2f(__builtin_amdgcn_fmed3f(xb[j], -CL, CL)); }
                        ta = ta + 1.0f; tb = tb + 1.0f;
                        f32x4 inv = ta * tb;
#pragma unroll
                        for (int j = 0; j < 4; ++j) inv[j] = __builtin_amdgcn_rcpf(inv[j]);
                        sb[n] = ta * (inv * 255.f); r[n] = tb * tb * inv; }
                    const unsigned o = o0 + (unsigned)((ai * 4 + m) * 1024);
                    st16(GR + o, pack8(r[0], r[1]));
                    unsigned q0 = 0u, q1 = 0u;
#pragma unroll
                    for (int j = 0; j < 4; ++j) { q0 = __builtin_amdgcn_cvt_pk_u8_f32(sb[0][j], j, q0); q1 = __builtin_amdgcn_cvt_pk_u8_f32(sb[1][j], j, q1); }
                    *(u32x2*)(GB + (o >> 1)) = (u32x2){q0, q1};
                    asm volatile("" ::: "memory"); }
        }
    }
};

struct EpiBranch {
    static constexpr bool PERM = true, MID = true;
    unsigned char* ws; bool f8out;
    __device__ __forceinline__ void mid(AccT& acc, const Unit& u, int wr, int wc, int fr, int fq) const {
        const char* GR = (const char*)(ws + WS_GR);
        const unsigned o0 = ((unsigned)((u.pm * 16 + 2 * u.pn) * 8 + wr * 4 + wc) * 8u) * 1024u + (unsigned)launder_v(fq * 16 + fr) * 16u;
        u32x4 g[2][4][2];
#pragma unroll
        for (int ai = 0; ai < 2; ++ai)
#pragma unroll
            for (int m = 0; m < 4; ++m)
#pragma unroll
                for (int bj = 0; bj < 2; ++bj) g[ai][m][bj] = *(const u32x4*)(GR + o0 + (unsigned)(bj * 65536 + (ai * 4 + m) * 1024));
#pragma unroll
        for (int ai = 0; ai < 2; ++ai)
#pragma unroll
            for (int m = 0; m < 4; ++m)
#pragma unroll
                for (int bj = 0; bj < 2; ++bj) { acc[ai][bj][m][0] *= unlo(g[ai][m][bj]); acc[ai][bj][m][1] *= unhi(g[ai][m][bj]); }
    }
    __device__ __forceinline__ void operator()(const AccT& acc, const Unit& u, int wr, int wc, int fr, int fq) const {
        const int row0 = launder_v(u.pm * 256 + wr * 64 + fr); const char* GB = (const char*)(ws + WS_GB); char* OUT = (char*)(ws + WS_XN);
        const unsigned o0 = ((unsigned)row0 * D + u.pn * 256 + wc * 32 + 8 * fq);
        const unsigned g0 = ((unsigned)((u.pm * 16 + 2 * u.pn) * 8 + wr * 4 + wc) * 8u) * 1024u + (unsigned)(fq * 16 + fr) * 16u;
        u32x2 g[2][4][2];
#pragma unroll
        for (int ai = 0; ai < 2; ++ai)
#pragma unroll
            for (int m = 0; m < 4; ++m)
#pragma unroll
                for (int bj = 0; bj < 2; ++bj) g[ai][m][bj] = *(const u32x2*)(GB + ((g0 + (unsigned)(bj * 65536 + (ai * 4 + m) * 1024)) >> 1));
#pragma unroll
        for (int ai = 0; ai < 2; ++ai)
#pragma unroll
            for (int m = 0; m < 4; ++m)
#pragma unroll
                for (int bj = 0; bj < 2; ++bj) { const unsigned o = o0 + (unsigned)((ai * 128 + m * 16) * D + bj * 128);
                    const unsigned ga = g[ai][m][bj].x, gb = g[ai][m][bj].y; const float k255 = 1.0f / 255.f;
                    const f32x4 v0 = acc[ai][bj][m][0] * ((f32x4){(float)(ga & 255u), (float)((ga >> 8) & 255u), (float)((ga >> 16) & 255u), (float)(ga >> 24)} * k255),
                                v1 = acc[ai][bj][m][1] * ((f32x4){(float)(gb & 255u), (float)((gb >> 8) & 255u), (float)((gb >> 16) & 255u), (float)(gb >> 24)} * k255);
                    if (f8out) *(u32x2*)(OUT + o) = (u32x2){pk4_fp8(v0[0], v0[1], v0[2], v0[3]), pk4_fp8(v1[0], v1[1], v1[2], v1[3])};
                    else *(u32x4*)(OUT + 2u * o) = pack8(v0, v1); }
    }
};

struct EpiOut {
    static constexpr bool PERM = true, MID = false;
    unsigned char* ws;
    __device__ __forceinline__ void mid(AccT&, const Unit&, int, int, int, int) const {}
    __device__ __forceinline__ void operator()(const AccT& acc, const Unit& u, int wr, int wc, int fr, int fq) const {
        const int row0 = launder_v(u.pm * 256 + wr * 64 + fr); char* Y = (char*)(ws + WS_DELTA);
        const unsigned o0 = ((unsigned)row0 * D + u.pn * 256 + wc * 32 + 8 * fq) * 2u;
#pragma unroll
        for (int ai = 0; ai < 2; ++ai)
#pragma unroll
            for (int m = 0; m < 4; ++m) {
#pragma unroll
                for (int bj = 0; bj < 2; ++bj) *(u32x4*)(Y + o0 + (unsigned)(((ai * 128 + m * 16) * D + bj * 128) * 2)) = pack8(acc[ai][bj][m][0], acc[ai][bj][m][1]);
                asm volatile("" ::: "memory"); }
    }
};

struct EpiGU {
    static constexpr bool PERM = true, MID = false;
    unsigned char* ws;
    __device__ __forceinline__ void mid(AccT&, const Unit&, int, int, int, int) const {}
    __device__ __forceinline__ void operator()(const AccT& acc, const Unit& u, int wr, int wc, int fr, int fq) const {
        const int rl0 = launder_v(wr * 64 + fr); const int row0 = u.pm * 256 + rl0; char* HM = (char*)(ws + WS_HMID);
        const char* RL = (const char*)(ws + WS_TOKLIST); const unsigned rb0 = (unsigned)(u.e * LISTCAP + u.rbl * 256) * 8u + 4u; const int vmax = u.nvalid - 1;
        const unsigned o0 = ((unsigned)row0 * DE + u.pn * 128 + wc * 32 + 8 * fq);
        float rsv[2][4];
#pragma unroll
        for (int ai = 0; ai < 2; ++ai)
#pragma unroll
            for (int m = 0; m < 4; ++m) { int rl = rl0 + ai * 128 + m * 16; rl = rl < vmax ? rl : vmax;
                rsv[ai][m] = *(const float*)(RL + rb0 + (unsigned)rl * 8u); }
#pragma unroll
        for (int ai = 0; ai < 2; ++ai)
#pragma unroll
            for (int m = 0; m < 4; ++m) { const float rs = rsv[ai][m];
                f32x4 h[2];
#pragma unroll
                for (int n = 0; n < 2; ++n) { const f32x4 g = acc[ai][0][m][n] * rs, up = acc[ai][1][m][n] * rs, z = g * -1.44269504f; f32x4 t;
#pragma unroll
                    for (int j = 0; j < 4; ++j) t[j] = __builtin_amdgcn_exp2f(z[j]);
                    t = t + 1.0f;
#pragma unroll
                    for (int j = 0; j < 4; ++j) t[j] = __builtin_amdgcn_rcpf(t[j]);
                    h[n] = (g * t) * up; }
                *(u32x2*)(HM + o0 + (unsigned)((ai * 128 + m * 16) * DE)) = (u32x2){pk4_fp8(h[0][0], h[0][1], h[0][2], h[0][3]), pk4_fp8(h[1][0], h[1][1], h[1][2], h[1][3])};
                asm volatile("" ::: "memory"); }
    }
};

struct EpiDown {
    static constexpr bool PERM = true, MID = false;
    unsigned char* ws; bool f8out;
    __device__ __forceinline__ void mid(AccT&, const Unit&, int, int, int, int) const {}
    __device__ __forceinline__ void operator()(const AccT& acc, const Unit& u, int wr, int wc, int fr, int fq) const {
        const int row0 = launder_v(u.pm * 256 + wr * 64 + fr); char* Y = (char*)(ws + WS_YSLOT);
        const unsigned o0 = ((unsigned)row0 * D + u.pn * 256 + wc * 32 + 8 * fq);
#pragma unroll
        for (int ai = 0; ai < 2; ++ai)
#pragma unroll
            for (int m = 0; m < 4; ++m) {
#pragma unroll
                for (int bj = 0; bj < 2; ++bj) { const unsigned o = o0 + (unsigned)((ai * 128 + m * 16) * D + bj * 128);
                    if (f8out) { f32x4 v0 = acc[ai][bj][m][0] * 16.f, v1 = acc[ai][bj][m][1] * 16.f;
#pragma unroll
                        for (int j = 0; j < 4; ++j) { v0[j] = __builtin_amdgcn_fmed3f(v0[j], -448.f, 448.f); v1[j] = __builtin_amdgcn_fmed3f(v1[j], -448.f, 448.f); }
                        *(u32x2*)(Y + o) = (u32x2){pk4_fp8(v0[0], v0[1], v0[2], v0[3]), pk4_fp8(v1[0], v1[1], v1[2], v1[3])}; }
                    else *(u32x4*)(Y + 2u * o) = pack8(acc[ai][bj][m][0], acc[ai][bj][m][1]); }
                asm volatile("" ::: "memory"); }
    }
};

struct Args { const float* in[20]; float* out; unsigned char* ws; };
#define CAS __attribute__((address_space(4)))
typedef const CAS unsigned char* kptr_t;
__device__ __forceinline__ const float* arg_in(kptr_t kp, int i) { const GAS float* p = *(const GAS float* const CAS*)(kp + 8 * i); return (const float*)p; }
__device__ __forceinline__ float* arg_out(kptr_t kp) { GAS float* p = *(GAS float* const CAS*)(kp + 160); return (float*)p; }
__device__ __forceinline__ unsigned char* arg_ws(kptr_t kp) { GAS unsigned char* p = *(GAS unsigned char* const CAS*)(kp + 168); return (unsigned char*)p; }
struct Frame {
    LAS unsigned char* lds; volatile LAS unsigned* MISC; unsigned* ctl;
    int tid, lane, wave, vcu, G;
    kptr_t kp; float* out; unsigned char* ws;
};
__device__ __forceinline__ int launder_s(int x) { asm volatile("" : "+s"(x)); return x; }
__device__ __forceinline__ kptr_t launder_k(kptr_t p) { asm volatile("" : "+s"(p)); return p; }
__device__ __forceinline__ void phase_frame(const struct Frame& F, struct Frame& P);
enum { I_X = 0, I_N1G, I_WIN, I_BGATE, I_CONVW, I_LNVG, I_LNVB, I_SGUW, I_SGUB, I_WBR, I_WOUT, I_N2G, I_RG, I_RGB, I_RE, I_REB, I_WGATE, I_WUP, I_WDOWN, I_FG };

__device__ __forceinline__ void phase_frame(const Frame& F, Frame& P) {
    P = F; P.wave = launder_s(F.wave); { int ln_; asm volatile("v_mbcnt_lo_u32_b32 %0, -1, 0\n\tv_mbcnt_hi_u32_b32 %0, -1, %0" : "=&v"(ln_)); P.lane = ln_; } P.tid = P.wave * 64 + P.lane;     P.kp = launder_k(F.kp); P.ws = arg_ws(P.kp); P.out = arg_out(P.kp); P.ctl = (unsigned*)(P.ws + WS_CTL); P.vcu = launder_s(F.vcu);
}
__device__ __forceinline__ int win_map(int n0) {
    if (n0 < 1024) return 256 * (n0 >> 7) + (n0 & 127);
    if (n0 < 2048) return 256 * 8 + (n0 - 1024);
    if (n0 < 3072) { const int j = n0 - 2048; return 256 * (j >> 7) + 128 + (j & 127); }
    if (n0 < 4096) return 256 * 12 + (n0 - 3072);
    if (n0 < 5120) return 256 * 16 + (n0 - 4096);
    if (n0 < 7168) { const int d = n0 - 5120; return 256 * 20 + 256 * (d >> 7) + (d & 127); }
    { const int d = n0 - 7168; return 256 * 20 + 256 * (d >> 7) + 128 + (d & 127); }
}
struct TrItem { const float* src; bf16* dst; int N, ldk, kcol0, k0, n0, drow0, f8; };
constexpr int IT_WIN = 32 * 144, IT_WBR = 16 * 32, IT_WOUT = 32 * 32, IT_EXP = 256, IT_LAYER = IT_WIN + 2 * IT_WBR + IT_WOUT + 3 * 32 * IT_EXP, IT_TOTAL = DEPTH * IT_LAYER;
__device__ __forceinline__ void p0_decode(const Frame& F, int it, TrItem& t) {
    const int l = it / IT_LAYER; int r = it - l * IT_LAYER;
    unsigned char* ws = F.ws;
    if (r < IT_WIN) { const int kb = r / 144, nb = r - kb * 144; t.src = arg_in(F.kp, I_WIN) + (size_t)l * D * DIN; t.N = DIN; t.ldk = D; t.kcol0 = 0; t.k0 = kb * 64; t.n0 = nb * 64;
        const int dr = win_map(nb * 64), split = l >= G1_F8_FROM ? G1_SPLIT : 5120;
        if (dr < split) { t.dst = (bf16*)(ws + WS_WIN) + (size_t)l * DIN * D; t.drow0 = dr; t.f8 = 0; }
        else { t.dst = (bf16*)(ws + WS_WIN8 + (size_t)l * 6144 * D); t.drow0 = dr - split; t.f8 = 1; }
        return; }
    r -= IT_WIN;
    if (r < 2 * IT_WBR) { const int br = r / IT_WBR; r -= br * IT_WBR; const int kb = r >> 5, nb = r & 31; t.src = arg_in(F.kp, I_WBR) + (size_t)(l * 2 + br) * CW * D; t.N = D; t.dst = (bf16*)(ws + WS_WBR) + (size_t)l * D * D; t.ldk = D; t.kcol0 = br * CW; t.k0 = kb * 64; t.n0 = nb * 64; t.drow0 = nb * 64; t.f8 = (l >= G2_F8_FROM); return; }
    r -= 2 * IT_WBR;
    if (r < IT_WOUT) { const int kb = r >> 5, nb = r & 31; t.src = arg_in(F.kp, I_WOUT) + (size_t)l * D * D; t.N = D; t.dst = (bf16*)(ws + WS_WOUT) + (size_t)l * D * D; t.ldk = D; t.kcol0 = 0; t.k0 = kb * 64; t.n0 = nb * 64; t.drow0 = nb * 64; t.f8 = (l >= G3_F8_FROM); return; }
    r -= IT_WOUT;
    const int type = r / (32 * IT_EXP); r -= type * 32 * IT_EXP; const int e = r / IT_EXP; r -= e * IT_EXP;
    if (type < 2) { const int kb = r >> 3, nb = r & 7, n0 = nb * 64; t.src = (type == 0 ? arg_in(F.kp, I_WGATE) : arg_in(F.kp, I_WUP)) + (size_t)(l * NE + e) * D * DE; t.N = DE; t.dst = (bf16*)(ws + WS_WGU + (size_t)(l * NE + e) * 1024 * D); t.ldk = D; t.kcol0 = 0; t.k0 = kb * 64; t.n0 = n0; t.f8 = 1;
        t.drow0 = 256 * (n0 >> 7) + (type == 1 ? 128 : 0) + (n0 & 127); return; }
    { const int kb = r >> 5, nb = r & 31; t.src = arg_in(F.kp, I_WDOWN) + (size_t)(l * NE + e) * DE * D; t.N = D; t.dst = (bf16*)(ws + WS_WD + (size_t)(l * NE + e) * D * DE); t.ldk = DE; t.kcol0 = 0; t.k0 = kb * 64; t.n0 = nb * 64; t.drow0 = nb * 64; t.f8 = 1; }
}
__device__ __forceinline__ void p0_load(const TrItem& t, int lane, float (&v)[64]) {
    const float* p = t.src + (size_t)t.k0 * t.N + t.n0 + lane;
#pragma unroll
    for (int i = 0; i < 64; ++i) v[i] = __builtin_nontemporal_load(p + (size_t)i * t.N);
}

__device__ __forceinline__ f32x4 ydec_lo(const u32x4 y) { return unlo(y); }
__device__ __forceinline__ f32x4 ydec_hi(const u32x4 y) { return unhi(y); }
__device__ __forceinline__ f32x4 ydec_lo(const u32x2 y) { const f32x2 a = __builtin_amdgcn_cvt_pk_f32_fp8((int)y.x, false), b = __builtin_amdgcn_cvt_pk_f32_fp8((int)y.x, true); return (f32x4){a.x, a.y, b.x, b.y}; }
__device__ __forceinline__ f32x4 ydec_hi(const u32x2 y) { const f32x2 a = __builtin_amdgcn_cvt_pk_f32_fp8((int)y.y, false), b = __builtin_amdgcn_cvt_pk_f32_fp8((int)y.y, true); return (f32x4){a.x, a.y, b.x, b.y}; }
template <bool Y8> struct YRow { typedef u32x4 T; };
template <> struct YRow<true> { typedef u32x2 T; };
template <int MODE> __device__ __forceinline__ void row_pass(const Frame& F, const float* gain) {
    const int lane = F.lane; const int gw = F.wave * F.G + F.vcu, NGW = F.G * NWAVES;
    const float* src = arg_in(F.kp, I_X); const bf16* Hs = (const bf16*)(F.ws + (MODE == 2 ? WS_H1 : WS_H)); bf16* Hd = (bf16*)(F.ws + (MODE == 0 ? WS_H : WS_H1));
    const bf16* DL = (const bf16*)(F.ws + WS_DELTA);
    bf16* XN = (bf16*)(F.ws + WS_XN);
    constexpr bool Y8 = (MODE == 2 ? DEPTH - 1 : 0) >= YS_F8_FROM;
    typedef typename YRow<Y8>::T YT; constexpr int YB = Y8 ? 1 : 2;
    const unsigned char* Y = F.ws + WS_YSLOT; const float ysc = Y8 ? 0.0625f : 1.0f;
    const LAS int* rbs = (const LAS int*)(F.lds + MISC_OFF + 64);
    f32x4 g[4][2];
#pragma unroll
    for (int j = 0; j < 4; ++j) { g[j][0] = *(const f32x4*)(gain + 512 * j + 8 * lane); g[j][1] = *(const f32x4*)(gain + 512 * j + 8 * lane + 4); }
    f32x4 hA[4][2], hB[4][2]; u32x4 rA[4], rB[4]; u32x4 dA[4], dB[4]; YT yA0[4], yA1[4], yB0[4], yB1[4]; f32x2 wA = (f32x2){0.f, 0.f}, wB = (f32x2){0.f, 0.f};
    u32x4 rec = (u32x4){0u, 0u, 0u, 0u}; f32x2 recw = (f32x2){0.f, 0.f};
#define RP_REC(row_) do { if (MODE != 0 && (row_) < NTOK) { rec = *(const u32x4*)(F.ws + WS_TOKINFO + (size_t)(row_) * 32); recw = *(const f32x2*)(F.ws + WS_TOKINFO + (size_t)(row_) * 32 + 16); } } while (0)
#define RP_LOAD(h_, r_, d_, y0_, y1_, w_, row_) do { if ((row_) < NTOK) { \
        _Pragma("unroll") for (int j = 0; j < 4; ++j) { \
            if constexpr (MODE == 0) { h_[j][0] = *(const f32x4*)(src + (size_t)(row_) * D + 512 * j + 8 * lane); h_[j][1] = *(const f32x4*)(src + (size_t)(row_) * D + 512 * j + 8 * lane + 4); } \
            else r_[j] = *(const u32x4*)(Hs + (size_t)(row_) * D + 512 * j + 8 * lane); } \
        if constexpr (MODE != 0) { const int s0 = 256 * rbs[rec.x] + (int)rec.y, s1 = 256 * rbs[rec.z] + (int)rec.w; w_ = recw * ysc; \
            _Pragma("unroll") for (int j = 0; j < 4; ++j) { d_[j] = *(const u32x4*)(DL + (size_t)(row_) * D + 512 * j + 8 * lane); \
                y0_[j] = *(const YT*)(Y + ((size_t)s0 * D + 512 * j + 8 * lane) * YB); y1_[j] = *(const YT*)(Y + ((size_t)s1 * D + 512 * j + 8 * lane) * YB); } } } } while (0)
#define RP_DO(h_, r_, d_, y0_, y1_, w_, row_) do { \
        if constexpr (MODE != 0) { _Pragma("unroll") for (int j = 0; j < 4; ++j) { \
            h_[j][0] = unlo(r_[j]) + unlo(d_[j]) + w_.x * ydec_lo(y0_[j]) + w_.y * ydec_lo(y1_[j]); h_[j][1] = unhi(r_[j]) + unhi(d_[j]) + w_.x * ydec_hi(y0_[j]) + w_.y * ydec_hi(y1_[j]); } } \
        float ss = 0.f; \
        _Pragma("unroll") for (int j = 0; j < 4; ++j) _Pragma("unroll") for (int q = 0; q < 2; ++q) ss += (h_[j][q][0] * h_[j][q][0] + h_[j][q][1] * h_[j][q][1]) + (h_[j][q][2] * h_[j][q][2] + h_[j][q][3] * h_[j][q][3]); \
        const float rstd = 1.0f / sqrtf(wave_sum(ss) * (1.0f / D) + EPS); \
        _Pragma("unroll") for (int j = 0; j < 4; ++j) { \
            if constexpr (MODE != 2) *(u32x4*)(Hd + (size_t)(row_) * D + 512 * j + 8 * lane) = pack8(h_[j][0], h_[j][1]); \
            const f32x4 o0 = h_[j][0] * rstd * g[j][0], o1 = h_[j][1] * rstd * g[j][1]; \
            if constexpr (MODE == 2) { *(f32x4*)(F.out + (size_t)(row_) * D + 512 * j + 8 * lane) = o0; *(f32x4*)(F.out + (size_t)(row_) * D + 512 * j + 8 * lane + 4) = o1; } \
            else { *(u32x4*)(XN + (size_t)(row_) * D + 512 * j + 8 * lane) = pack8(o0, o1); \
                *(u32x2*)(F.ws + WS_XN8 + (size_t)(row_) * D + 512 * j + 8 * lane) = (u32x2){pk4_fp8(o0[0], o0[1], o0[2], o0[3]), pk4_fp8(o1[0], o1[1], o1[2], o1[3])}; } } } while (0)
    RP_REC(gw);
    RP_LOAD(hA, rA, dA, yA0, yA1, wA, gw);
    RP_REC(gw + NGW);
#pragma unroll 1
    for (int row = gw; row < NTOK; row += 2 * NGW) {
        RP_LOAD(hB, rB, dB, yB0, yB1, wB, row + NGW);
        RP_REC(row + 2 * NGW);
        RP_DO(hA, rA, dA, yA0, yA1, wA, row);
        if (row + NGW < NTOK) {
            RP_LOAD(hA, rA, dA, yA0, yA1, wA, row + 2 * NGW);
            RP_REC(row + 3 * NGW);
            RP_DO(hB, rB, dB, yB0, yB1, wB, row + NGW);
        }
    }
#undef RP_REC
#undef RP_LOAD
#undef RP_DO
}

template <int PM  > __device__ __forceinline__ void p0_prologue(const Frame& F) {
    LAS float* scr = (LAS float*)(F.lds + F.wave * P0_SCR);
    const int lane = F.lane, gw = F.vcu * NWAVES + F.wave, NGW = F.G * NWAVES;
    {
        TrItem cur, nxt; float v[64];
        int it = gw; bool have = it < IT_TOTAL;
        if (have) { p0_decode(F, it, cur); p0_load(cur, lane, v); }
#pragma unroll 1
        while (have) {
#pragma unroll
            for (int i = 0; i < 64; ++i) scr[i * 65 + lane] = v[i];
            LDS_WAIT(); asm volatile("" ::: "memory");
            const int itn = it + NGW; const bool haven = itn < IT_TOTAL;
            if (haven) { p0_decode(F, itn, nxt); p0_load(nxt, lane, v); }
            const int c = lane & 7;
#pragma unroll
            for (int j = 0; j < 8; ++j) { const int n = (lane >> 3) + 8 * j; const LAS float* s = scr + (8 * c) * 65 + n;
                const size_t eo = (size_t)(cur.drow0 + n) * cur.ldk + cur.kcol0 + cur.k0 + 8 * c;
                if (cur.f8) { u32x2 o; o.x = pk4_fp8(32.f * s[0 * 65], 32.f * s[1 * 65], 32.f * s[2 * 65], 32.f * s[3 * 65]); o.y = pk4_fp8(32.f * s[4 * 65], 32.f * s[5 * 65], 32.f * s[6 * 65], 32.f * s[7 * 65]);
                    __builtin_nontemporal_store(o, (u32x2*)((unsigned char*)cur.dst + eo)); }
                else { u32x4 o; o.x = cvt_pk_bf16(s[0 * 65], s[1 * 65]); o.y = cvt_pk_bf16(s[2 * 65], s[3 * 65]); o.z = cvt_pk_bf16(s[4 * 65], s[5 * 65]); o.w = cvt_pk_bf16(s[6 * 65], s[7 * 65]);
                    __builtin_nontemporal_store(o, (u32x4*)(cur.dst + eo)); } }
            LDS_WAIT(); asm volatile("" ::: "memory");
            cur = nxt; it = itn; have = haven;
        }
    }
    if (PM == 0) {
        bf16* RT = (bf16*)(F.ws + WS_RT);
        for (int idx = (F.vcu * NWAVES + F.wave) * 64 + lane; idx < DEPTH * 48 * D; idx += NGW * 64) {
            const int l = idx / (48 * D), r = idx - l * 48 * D, e = r / D, k = r - e * D;
            float w = 0.f; if (e < 4) w = arg_in(F.kp, I_RG)[(size_t)(l * D + k) * NGRP + e]; else if (e < 36) w = arg_in(F.kp, I_RE)[(size_t)(l * D + k) * NE + (e - 4)];
            const unsigned hi = cvt_pk_bf16(w, 0.f) & 0xffffu; const float rem = w - __uint_as_float(hi << 16); const unsigned lo = cvt_pk_bf16(rem, 0.f) & 0xffffu;
            RT[(size_t)(l * 2 + 0) * 48 * D + r] = (bf16)hi; RT[(size_t)(l * 2 + 1) * 48 * D + r] = (bf16)lo;
        }
    }
    if (PM == 0) row_pass<0>(F, arg_in(F.kp, I_N1G));
}

__device__ __forceinline__ void mid_phase(const Frame& F, int l) {
    LAS bf16* WL = (LAS bf16*)F.lds;
    LAS bf16* VT = (LAS bf16*)(F.lds + 34816);
    LAS float* ST = (LAS float*)(F.lds + 69632);
    LAS bf16* MX = (LAS bf16*)(F.lds + 70656);
    const int tid = F.tid, lane = F.lane, w = F.wave, fr = lane & 15, fq = lane >> 4; const bool f8 = l >= G2_F8_FROM;
    const bf16* XC = (const bf16*)(F.ws + WS_XC); const bf16* BB = (const bf16*)(F.ws + WS_BB); const bf16* U = (const bf16*)(F.ws + WS_U); const bf16* V = (const bf16*)(F.ws + WS_V);
    const f32x2* VST = (const f32x2*)(F.ws + WS_VSTAT); bf16* YAB = (bf16*)(F.ws + WS_YAB);
    const int per = (1024 + F.G - 1) / F.G; const int it0 = F.vcu * per, it1 = (it0 + per) < 1024 ? (it0 + per) : 1024;
    int gcur = -1;
    const int cc = (tid & 15) * 8;
#pragma unroll 1
    for (int it = it0; it < it1; ++it) {
        const int g = it >> 7, ch = it & 127, row0 = ch * CHUNK;
        f32x4 w0[2], w1[2], w2[2], lg0, lg1, lb0, lb1; float sbv[8];
        {
            const float* cw = arg_in(F.kp, I_CONVW) + (size_t)l * 3 * CW + g * 128 + cc;
#pragma unroll
            for (int q = 0; q < 2; ++q) { w0[q] = *(const f32x4*)(cw + 4 * q); w1[q] = *(const f32x4*)(cw + CW + 4 * q); w2[q] = *(const f32x4*)(cw + 2 * CW + 4 * q); }
        }
        u32x4 X0[4], X1[4], X2[4], BBv[4], Vv[4], UU[4]; f32x2 SP[16];
        {
            const u32x4 z = (u32x4){0u, 0u, 0u, 0u};
#pragma unroll
            for (int i = 0; i < 4; ++i) { const int t = (tid >> 4) + 32 * i, row = row0 + t, ts = row & (SEQ - 1); const size_t o = (size_t)row * CW + g * 128 + cc;
                X0[i] = *(const u32x4*)(XC + o); X1[i] = ts >= 1 ? *(const u32x4*)(XC + o - CW) : z; X2[i] = ts >= 2 ? *(const u32x4*)(XC + o - 2 * CW) : z; BBv[i] = *(const u32x4*)(BB + o); }
            if (tid < 128) {
#pragma unroll
                for (int i = 0; i < 16; ++i) SP[i] = VST[(size_t)(row0 + tid) * 16 + i]; }
#pragma unroll
            for (int i = 0; i < 4; ++i) Vv[i] = *(const u32x4*)(V + (size_t)(row0 + (tid >> 4) + 32 * i) * CW + g * 128 + cc);
#pragma unroll
            for (int i = 0; i < 4; ++i) UU[i] = *(const u32x4*)(U + (size_t)(row0 + (tid >> 4) + 32 * i) * CW + g * 128 + cc);
        }
        {
#pragma unroll
            for (int i = 0; i < 4; ++i) { const int t = (tid >> 4) + 32 * i, row = row0 + t;
                const unsigned A0[4] = {X0[i].x, X0[i].y, X0[i].z, X0[i].w}, A1[4] = {X1[i].x, X1[i].y, X1[i].z, X1[i].w}, A2[4] = {X2[i].x, X2[i].y, X2[i].z, X2[i].w}, Bq[4] = {BBv[i].x, BBv[i].y, BBv[i].z, BBv[i].w};
                float yl[4], yh[4];
#pragma unroll
                for (int p = 0; p < 4; ++p) { const int q = p >> 1, e = (p & 1) * 2;
                    yl[p] = bflo(Bq[p]) * (w0[q][e] * bflo(A2[p]) + w1[q][e] * bflo(A1[p]) + w2[q][e] * bflo(A0[p]));
                    yh[p] = bfhi(Bq[p]) * (w0[q][e + 1] * bfhi(A2[p]) + w1[q][e + 1] * bfhi(A1[p]) + w2[q][e + 1] * bfhi(A0[p])); }
                if (f8) {
#pragma unroll
                    for (int p = 0; p < 4; ++p) { yl[p] = __builtin_amdgcn_fmed3f(yl[p], -448.f, 448.f); yh[p] = __builtin_amdgcn_fmed3f(yh[p], -448.f, 448.f); }
                    *(u32x2*)((unsigned char*)YAB + (size_t)row * D + g * 128 + cc) = (u32x2){pk4_fp8(yl[0], yh[0], yl[1], yh[1]), pk4_fp8(yl[2], yh[2], yl[3], yh[3])}; }
                else *(u32x4*)(YAB + (size_t)row * D + g * 128 + cc) = (u32x4){cvt_pk_bf16(yl[0], yh[0]), cvt_pk_bf16(yl[1], yh[1]), cvt_pk_bf16(yl[2], yh[2]), cvt_pk_bf16(yl[3], yh[3])}; }
        }
        {
            const float* lg = arg_in(F.kp, I_LNVG) + l * CW + g * 128 + cc; const float* lb = arg_in(F.kp, I_LNVB) + l * CW + g * 128 + cc;
            lg0 = *(const f32x4*)lg; lg1 = *(const f32x4*)(lg + 4); lb0 = *(const f32x4*)lb; lb1 = *(const f32x4*)(lb + 4);
            const float* sb = arg_in(F.kp, I_SGUB) + (size_t)(l * SG + g) * CHUNK;
#pragma unroll
            for (int tt = 0; tt < 8; ++tt) sbv[tt] = sb[16 * tt + fr];
        }
        __syncthreads();
        if (g != gcur) {
            const float* Wg = arg_in(F.kp, I_SGUW) + (size_t)(l * SG + g) * CHUNK * CHUNK;
#pragma unroll
            for (int i = 0; i < 8; ++i) { const int idx4 = tid + 512 * i, t = idx4 >> 5, s4 = (idx4 & 31) * 4; const f32x4 wv = *(const f32x4*)(Wg + t * CHUNK + s4);
                u32x2 o; o.x = cvt_pk_bf16(s4 + 0 <= t ? wv[0] : 0.f, s4 + 1 <= t ? wv[1] : 0.f); o.y = cvt_pk_bf16(s4 + 2 <= t ? wv[2] : 0.f, s4 + 3 <= t ? wv[3] : 0.f);
                *(LAS u32x2*)(WL + t * 136 + s4) = o; }
            gcur = g;
        }
        if (tid < 128) { float s = 0.f, q = 0.f;
#pragma unroll
            for (int i = 0; i < 16; ++i) { s += SP[i].x; q += SP[i].y; }
            const float mu = s * (1.0f / CW), var = q * (1.0f / CW) - mu * mu; ST[tid * 2] = mu; ST[tid * 2 + 1] = 1.0f / sqrtf(fmaxf(var, 0.f) + EPS); }
        __syncthreads();
        {
#pragma unroll
            for (int i = 0; i < 4; ++i) { const int s = (tid >> 4) + 32 * i; const u32x4 v = Vv[i];
                const float mu = ST[s * 2], rs = ST[s * 2 + 1];
                const float x[8] = {bflo(v.x), bfhi(v.x), bflo(v.y), bfhi(v.y), bflo(v.z), bfhi(v.z), bflo(v.w), bfhi(v.w)};
                float y[8];
#pragma unroll
                for (int j = 0; j < 8; ++j) { const float lgj = j < 4 ? lg0[j & 3] : lg1[j & 3], lbj = j < 4 ? lb0[j & 3] : lb1[j & 3]; y[j] = (x[j] - mu) * rs * lgj + lbj; }
                *(LAS u32x4*)(VT + s * 136 + cc) = (u32x4){cvt_pk_bf16(y[0], y[1]), cvt_pk_bf16(y[2], y[3]), cvt_pk_bf16(y[4], y[5]), cvt_pk_bf16(y[6], y[7])}; }
        }
        __syncthreads();
        {
            typedef short s16x4 __attribute__((ext_vector_type(4)));
            bf16x8 a[4];
            const LAS bf16* tp = VT + (8 * fq + (fr >> 2)) * 136 + 16 * w + 4 * (fr & 3);
#pragma unroll
            for (int ks = 0; ks < 4; ++ks) { const s16x4 lo4 = __builtin_amdgcn_ds_read_tr16_b64_v4i16((LAS s16x4*)(tp + 32 * ks * 136)), hi4 = __builtin_amdgcn_ds_read_tr16_b64_v4i16((LAS s16x4*)(tp + (32 * ks + 4) * 136));
                a[ks] = __builtin_shufflevector(lo4, hi4, 0, 1, 2, 3, 4, 5, 6, 7); }
#pragma unroll
            for (int tt = 0; tt < 8; ++tt) { f32x4 d = (f32x4){0.f, 0.f, 0.f, 0.f};
#pragma unroll
                for (int ks = 0; ks < 4; ++ks) if (32 * ks <= 16 * tt + 15) { const bf16x8 b = *(const LAS bf16x8*)(WL + (16 * tt + fr) * 136 + 32 * ks + 8 * fq); d = __builtin_amdgcn_mfma_f32_16x16x32_bf16(a[ks], b, d, 0, 0, 0); }
                const int t = 16 * tt + fr; const float bias = sbv[tt];
                *(LAS u32x2*)(MX + t * 136 + 16 * w + 4 * fq) = (u32x2){cvt_pk_bf16(d[0] + bias, d[1] + bias), cvt_pk_bf16(d[2] + bias, d[3] + bias)}; }
        }
        __syncthreads();
        {
#pragma unroll
            for (int i = 0; i < 4; ++i) { const int t = (tid >> 4) + 32 * i; const u32x4 mx = *(const LAS u32x4*)(MX + t * 136 + cc), uu = UU[i];
                float y[8] = {bflo(uu.x) * bflo(mx.x), bfhi(uu.x) * bfhi(mx.x), bflo(uu.y) * bflo(mx.y), bfhi(uu.y) * bfhi(mx.y), bflo(uu.z) * bflo(mx.z), bfhi(uu.z) * bfhi(mx.z), bflo(uu.w) * bflo(mx.w), bfhi(uu.w) * bfhi(mx.w)};
                if (f8) {
#pragma unroll
                    for (int j = 0; j < 8; ++j) y[j] = __builtin_amdgcn_fmed3f(y[j], -448.f, 448.f);
                    *(u32x2*)((unsigned char*)YAB + (size_t)(row0 + t) * D + CW + g * 128 + cc) = (u32x2){pk4_fp8(y[0], y[1], y[2], y[3]), pk4_fp8(y[4], y[5], y[6], y[7])}; }
                else *(u32x4*)(YAB + (size_t)(row0 + t) * D + CW + g * 128 + cc) = (u32x4){cvt_pk_bf16(y[0], y[1]), cvt_pk_bf16(y[2], y[3]), cvt_pk_bf16(y[4], y[5]), cvt_pk_bf16(y[6], y[7])}; }
        }
    }
    __syncthreads();
}

__device__ __forceinline__ void r2_phase(const Frame& F, int l, bool dry = false) {
    const int tid = F.tid, lane = F.lane, fr = lane & 15, fq = lane >> 4, pr = F.wave >> 1, kh = F.wave & 1;
    const bf16* H = (const bf16*)(F.ws + (l == 0 ? WS_H : WS_H1)); const bf16* DL = (const bf16*)(F.ws + WS_DELTA); unsigned char* XU8 = F.ws + WS_XN;
    const bf16* RTH = (const bf16*)(F.ws + WS_RT) + (size_t)(l * 2 + 0) * 48 * D; const bf16* RTL = (const bf16*)(F.ws + WS_RT) + (size_t)(l * 2 + 1) * 48 * D;
    const float* gain = arg_in(F.kp, I_N2G) + (size_t)l * D;
    constexpr int HBB = 64 * 272, DBB = 64 * 272;
    LAS float* GAIN = (LAS float*)F.lds;
    LAS unsigned char* HB = F.lds + 8192;
    LAS unsigned char* DB = F.lds + 8192 + 2 * HBB;
    LAS float* LG = (LAS float*)(F.lds + 8192 + F.wave * 4096);
    unsigned* cnt = F.ctl + CW_CNT + (l + (dry ? 2 : 0)) * 32 * 64; unsigned* toklist = (unsigned*)(F.ws + WS_TOKLIST);
    *(LAS f32x4*)(GAIN + 4 * tid) = *(const f32x4*)(gain + 4 * tid);
    float rgb[4], reb[32];
#pragma unroll
    for (int i = 0; i < 4; ++i) rgb[i] = arg_in(F.kp, I_RGB)[l * NGRP + i];
#pragma unroll
    for (int i = 0; i < 32; ++i) reb[i] = arg_in(F.kp, I_REB)[l * NE + i];
    const bf16* bh = RTH + (size_t)fr * D + 8 * fq; const bf16* bl = RTL + (size_t)fr * D + 8 * fq;
#pragma unroll 1
    for (int tg = F.vcu; tg < NTOK / 64; tg += F.G) {
        const int rowb = tg * 64, row0 = rowb + pr * 16;
        f32x4 acc[3] = {(f32x4){0.f, 0.f, 0.f, 0.f}, (f32x4){0.f, 0.f, 0.f, 0.f}, (f32x4){0.f, 0.f, 0.f, 0.f}};
        float ss = 0.f;
        const bf16* hsrc = H + (size_t)(rowb + (tid >> 4)) * D + 8 * (tid & 15); const bf16* dsrc = DL + (size_t)(rowb + (tid >> 4)) * D + 8 * (tid & 15);
        const int ddst = (tid >> 4) * 272 + (tid & 15) * 16, hdst = ddst;
        u32x4 hrE[2], drE[2], hrO[2], drO[2];
#define R2_BLOAD(BH, BL, kc_) do { const int kg0_ = (kc_) * 128 + 64 * kh; \
            _Pragma("unroll") for (int j = 0; j < 2; ++j) _Pragma("unroll") for (int eb = 0; eb < 3; ++eb) { BH[j][eb] = *(const bf16x8*)(bh + (size_t)(16 * eb) * D + kg0_ + 32 * j); if (ROUTER_SPLIT) BL[j][eb] = *(const bf16x8*)(bl + (size_t)(16 * eb) * D + kg0_ + 32 * j); } } while (0)
#define R2_HLOAD(hr, dr, kc_) do { _Pragma("unroll") for (int i = 0; i < 2; ++i) { hr[i] = *(const u32x4*)(hsrc + (size_t)(32 * i) * D + (kc_) * 128); dr[i] = *(const u32x4*)(dsrc + (size_t)(32 * i) * D + (kc_) * 128); } } while (0)
#define R2_HPUT(hr, dr, buf_) do { _Pragma("unroll") for (int i = 0; i < 2; ++i) { *(LAS u32x4*)(HB + (buf_) * HBB + hdst + i * 32 * 272) = hr[i]; *(LAS u32x4*)(DB + (buf_) * DBB + ddst + i * 32 * 272) = dr[i]; } } while (0)
        bf16x8 BHa[2][3], BLa[2][3], BHb[2][3], BLb[2][3];
        R2_HLOAD(hrE, drE, 0);
        __syncthreads();
        R2_HPUT(hrE, drE, 0);
        R2_BLOAD(BHa, BLa, 0);
        R2_HLOAD(hrO, drO, 1);
        __syncthreads();
#define R2_COMPUTE(BH, BL, kc_, buf_) do { \
            const int kg0 = (kc_) * 128 + 64 * kh; u32x2 Q[2]; \
            _Pragma("unroll") for (int j = 0; j < 2; ++j) { \
                const int kl = 64 * kh + 32 * j + 8 * fq; \
                const LAS unsigned char* hp = HB + (buf_) * HBB + (pr * 16 + fr) * 272 + kl * 2; const LAS unsigned char* dp = DB + (buf_) * DBB + (pr * 16 + fr) * 272 + kl * 2; \
                const u32x4 hv = *(const LAS u32x4*)hp; const f32x4 H0 = unlo(hv), H1 = unhi(hv); const u32x4 dl = *(const LAS u32x4*)dp; \
                const f32x4 G0 = *(const LAS f32x4*)(GAIN + (kc_) * 128 + kl), G1 = *(const LAS f32x4*)(GAIN + (kc_) * 128 + kl + 4); \
                const f32x4 h0 = H0 + unlo(dl), h1 = H1 + unhi(dl); \
                ss += (h0[0] * h0[0] + h0[1] * h0[1]) + (h0[2] * h0[2] + h0[3] * h0[3]) + (h1[0] * h1[0] + h1[1] * h1[1]) + (h1[2] * h1[2] + h1[3] * h1[3]); \
                const f32x4 x0 = h0 * G0, x1 = h1 * G1; \
                u32x4 hi; hi.x = cvt_pk_bf16(x0[0], x0[1]); hi.y = cvt_pk_bf16(x0[2], x0[3]); hi.z = cvt_pk_bf16(x1[0], x1[1]); hi.w = cvt_pk_bf16(x1[2], x1[3]); \
                Q[j] = (u32x2){pk4_fp8(x0[0], x0[1], x0[2], x0[3]), pk4_fp8(x1[0], x1[1], x1[2], x1[3])}; \
                const bf16x8 Ah = __builtin_bit_cast(bf16x8, hi); \
                if (ROUTER_SPLIT) { u32x4 lo; lo.x = cvt_pk_bf16(x0[0] - bflo(hi.x), x0[1] - bfhi(hi.x)); lo.y = cvt_pk_bf16(x0[2] - bflo(hi.y), x0[3] - bfhi(hi.y)); \
                    lo.z = cvt_pk_bf16(x1[0] - bflo(hi.z), x1[1] - bfhi(hi.z)); lo.w = cvt_pk_bf16(x1[2] - bflo(hi.w), x1[3] - bfhi(hi.w)); const bf16x8 Al = __builtin_bit_cast(bf16x8, lo); \
                    _Pragma("unroll") for (int eb = 0; eb < 3; ++eb) { acc[eb] = __builtin_amdgcn_mfma_f32_16x16x32_bf16(Al, BH[j][eb], acc[eb], 0, 0, 0); acc[eb] = __builtin_amdgcn_mfma_f32_16x16x32_bf16(Ah, BL[j][eb], acc[eb], 0, 0, 0); } } \
                _Pragma("unroll") for (int eb = 0; eb < 3; ++eb) acc[eb] = __builtin_amdgcn_mfma_f32_16x16x32_bf16(Ah, BH[j][eb], acc[eb], 0, 0, 0); } \
            _Pragma("unroll") for (int j = 0; j < 2; ++j) *(u32x2*)(XU8 + (size_t)(row0 + fr) * D + kg0 + 32 * j + 8 * fq) = Q[j]; } while (0)
#pragma unroll 1
        for (int kc = 0; kc < 16; kc += 2) {
            const int k2 = kc + 2 < 16 ? kc + 2 : 15, k3 = kc + 3 < 16 ? kc + 3 : 15;
            R2_BLOAD(BHb, BLb, kc + 1);
            R2_HLOAD(hrE, drE, k2);
            asm volatile("" ::: "memory");
            R2_COMPUTE(BHa, BLa, kc, 0);
            R2_HPUT(hrO, drO, 1);
            __syncthreads();
            R2_BLOAD(BHa, BLa, k2);
            R2_HLOAD(hrO, drO, k3);
            asm volatile("" ::: "memory");
            R2_COMPUTE(BHb, BLb, kc + 1, 1);
            R2_HPUT(hrE, drE, 0);
            __syncthreads();
        }
#undef R2_BLOAD
#undef R2_HLOAD
#undef R2_HPUT
#undef R2_COMPUTE
        if (tid < 32) F.MISC[640 + tid] = 0u;
        ss += __shfl_xor(ss, 16); ss += __shfl_xor(ss, 32);
#pragma unroll
        for (int eb = 0; eb < 3; ++eb)
#pragma unroll
            for (int j = 0; j < 4; ++j) LG[(4 * fq + j) * 48 + 16 * eb + fr] = acc[eb][j];
        if (fq == 0) LG[768 + fr] = ss;
        __syncthreads();
        const bool router = (kh == 0 && lane < 16);
        int row = 0, e1 = 0, e2 = 0; unsigned l1 = 0u, l2 = 0u; float rstd = 0.f, w1 = 0.f, w2 = 0.f;
        if (router) {
            row = row0 + lane; const LAS float* lg = LG + lane * 48; const LAS float* lg2 = lg + 1024;
            rstd = 1.0f / sqrtf((LG[768 + lane] + LG[1024 + 768 + lane]) * (1.0f / D) + EPS);
            float gl[4];
#pragma unroll
            for (int i = 0; i < 4; ++i) gl[i] = (lg[i] + lg2[i]) * rstd + rgb[i];
            int gi = 0; float gm = gl[0];
#pragma unroll
            for (int i = 1; i < 4; ++i) if (gl[i] > gm) { gm = gl[i]; gi = i; }
            float gs = 0.f;
#pragma unroll
            for (int i = 0; i < 4; ++i) gs += __expf(gl[i] - gm);
            const float gwt = 1.0f / gs;
            float el[8];
#pragma unroll
            for (int j = 0; j < 8; ++j) { const float b0 = gi == 0 ? reb[j] : (gi == 1 ? reb[8 + j] : (gi == 2 ? reb[16 + j] : reb[24 + j])); el[j] = (lg[4 + gi * 8 + j] + lg2[4 + gi * 8 + j]) * rstd + b0; }
            int i1 = 0; float m1 = el[0];
#pragma unroll
            for (int j = 1; j < 8; ++j) if (el[j] > m1) { m1 = el[j]; i1 = j; }
            int i2 = -1; float m2 = -3.0e38f;
#pragma unroll
            for (int j = 0; j < 8; ++j) if (j != i1 && el[j] > m2) { m2 = el[j]; i2 = j; }
            const float ex = __expf(m2 - m1); w1 = gwt / (1.0f + ex); w2 = gwt * ex / (1.0f + ex);
            e1 = gi * 8 + i1; e2 = gi * 8 + i2;
            l1 = __hip_atomic_fetch_add((LAS unsigned*)(F.lds + MISC_OFF) + 640 + e1, 1u, __ATOMIC_RELAXED, __HIP_MEMORY_SCOPE_WORKGROUP);
            l2 = __hip_atomic_fetch_add((LAS unsigned*)(F.lds + MISC_OFF) + 640 + e2, 1u, __ATOMIC_RELAXED, __HIP_MEMORY_SCOPE_WORKGROUP);
        }
        __syncthreads();
        if (tid < 32) { const unsigned c = F.MISC[640 + tid]; F.MISC[672 + tid] = c ? __hip_atomic_fetch_add(cnt + tid * 64, c, __ATOMIC_RELAXED, __HIP_MEMORY_SCOPE_AGENT) : 0u; }
        __syncthreads();
        if (router) {
            const unsigned r1 = F.MISC[672 + e1] + l1, r2 = F.MISC[672 + e2] + l2;
            *(u32x2*)(toklist + 2 * ((size_t)e1 * LISTCAP + r1)) = (u32x2){(unsigned)row, __float_as_uint(rstd)}; *(u32x2*)(toklist + 2 * ((size_t)e2 * LISTCAP + r2)) = (u32x2){(unsigned)row, __float_as_uint(rstd)};
            *(u32x4*)(F.ws + WS_TOKINFO + (size_t)row * 32) = (u32x4){(unsigned)e1, r1, (unsigned)e2, r2}; *(f32x2*)(F.ws + WS_TOKINFO + (size_t)row * 32 + 16) = (f32x2){w1, w2};
        }
        __syncthreads();
    }
}

__device__ __forceinline__ void moe_table(const Frame& F, int l) {
    const int tid = F.tid;
    __syncthreads();
    if (tid < 64) {
        const unsigned c = tid < 32 ? __hip_atomic_load(F.ctl + CW_CNT + (l * 32 + tid) * 64, __ATOMIC_RELAXED, __HIP_MEMORY_SCOPE_AGENT) : 0u;
        const int nb = (int)((c + 255u) >> 8); int incl = nb;
#pragma unroll
        for (int d = 1; d < 32; d <<= 1) { const int t = __shfl_up(incl, d); if (tid >= d) incl += t; }
        const int excl = incl - nb;
        if (tid < 32) { F.MISC[64 + tid] = c; F.MISC[16 + tid] = (unsigned)excl;
            for (int b = 0; b < nb; ++b) { F.MISC[320 + excl + b] = ((int)c - b * 256 > 128) ? 1u : 0u; F.MISC[480 + excl + b] = (unsigned)tid; } }
        if (tid == 31) { F.MISC[16 + 32] = (unsigned)incl; F.MISC[127] = (unsigned)((incl + 7) >> 3); }
    }
    __syncthreads();
    const int R = (int)F.MISC[48], rc = (int)F.MISC[127];
    if (tid < R) { const int full = (int)F.MISC[320 + tid]; const int lo = (tid / rc) * rc, hi = (lo + rc) < R ? (lo + rc) : R; int nfull = 0, before = 0;
        for (int r = lo; r < hi; ++r) { const int f = (int)F.MISC[320 + r]; nfull += f; before += (r < tid) ? f : 0; }
        F.MISC[128 + (full ? lo + before : lo + nfull + (tid - lo - before))] = (unsigned)tid; }
    __syncthreads();
}


__global__ void __launch_bounds__(NWAVES * 64, 2) mk_fwd(Args args) {
    __shared__ __attribute__((aligned(16))) unsigned char lds_raw[LDS_BYTES];
    Frame F;
    F.lds = (LAS unsigned char*)lds_raw; F.MISC = (volatile LAS unsigned*)(F.lds + MISC_OFF);
    F.tid = 0; F.lane = 0; F.wave = __builtin_amdgcn_readfirstlane((int)threadIdx.x >> 6);
    F.G = gridDim.x; { const int bx = blockIdx.x; F.vcu = (F.G % 8 == 0) ? (bx % 8) * (F.G / 8) + bx / 8 : bx; }
    F.kp = (kptr_t)__builtin_amdgcn_kernarg_segment_ptr(); F.ws = arg_ws(F.kp); F.out = arg_out(F.kp); F.ctl = (unsigned*)(F.ws + WS_CTL);
    for (int u = (int)threadIdx.x; u < (LDS_BYTES - MISC_OFF) / 4; u += NWAVES * 64) ((LAS unsigned*)(F.lds + MISC_OFF))[u] = 0u;
    __syncthreads();
    XcdBarrier bar = xcd_barrier_post(F.ctl + CW_BAR, F.MISC);
#define GRID_BAR() do { XcdBarrier b2_; b2_.x = (unsigned)launder_s((int)bar.x); b2_.st = F.MISC; b2_.bar = (unsigned*)(arg_ws(launder_k(F.kp)) + WS_CTL) + CW_BAR; xcd_barrier(b2_); } while (0)
    if (P0_PROBE) { { Frame P; phase_frame(F, P); p0_prologue<P0_PROBE>(P); } GRID_BAR(); }
    for (int rep = 0; rep < REP_P0; ++rep) { { Frame P; phase_frame(F, P); p0_prologue<0>(P); }
    GRID_BAR(); }

#pragma unroll 1
    for (int l = 0; l < DEPTH; ++l) {
        for (int rep = 0; rep < REP_G1; ++rep) {
#define G1_BF16_PART() do { Frame P; phase_frame(F, P); unsigned char* ws = P.ws; \
                pg8::DenseOrder S; S.init(NTOK, g1split, 2 * D, P.G, (int)blockIdx.x, ws + WS_XN, (const bf16*)(ws + WS_WIN) + (size_t)l * DIN * D); \
                EpiInProj E{ws, arg_in(P.kp, I_BGATE) + (size_t)l * 2 * D, 0, nullptr}; \
                pg8::gemm_phase<EpiInProj, pg8::DenseOrder, GM_G1, true, KREP_G1>(P.lds, P.tid, D, S, E); } while (0)
#define G1_FP8_PART() do { Frame P; phase_frame(F, P); unsigned char* ws = P.ws; \
                pg8::DenseOrder S; S.init(NTOK, DIN - g1split, D, P.G, (int)blockIdx.x, ws + WS_XN8, ws + WS_WIN8 + (size_t)l * 6144 * D); \
                { const float* bg_ = arg_in(P.kp, I_BGATE) + (size_t)l * 2 * D + 8 * P.tid; const f32x4 b0_ = *(const f32x4*)bg_ * -1.44269504f, b1_ = *(const f32x4*)(bg_ + 4) * -1.44269504f; \
                  *(LAS u32x4*)(P.lds + MISC_OFF + 2816 + 16 * P.tid) = pack8(b0_, b1_); __syncthreads(); } \
                EpiInProj E{ws, arg_in(P.kp, I_BGATE) + (size_t)l * 2 * D, g1split >> 8, (const LAS unsigned char*)(P.lds + MISC_OFF + 2816)}; \
                pg8::gemm_phase<EpiInProj, pg8::DenseOrder, GM_G1, true, 1, true>(P.lds, P.tid, D, S, E); } while (0)
            const bool fp8_first = ((blockIdx.x >> 3) & 1) != 0; const int g1split = l >= G1_F8_FROM ? G1_SPLIT : 5120;
#pragma unroll 1
            for (int step = 0; step < 2; ++step) { if ((step == 0) == fp8_first) G1_FP8_PART(); else G1_BF16_PART(); }
        GRID_BAR(); }
        for (int rep = 0; rep < REP_MID; ++rep) { { Frame P; phase_frame(F, P); mid_phase(P, l); }
        GRID_BAR(); }
        for (int rep = 0; rep < REP_G2; ++rep) {
            Frame P; phase_frame(F, P); unsigned char* ws = P.ws;
            const bool f8 = l >= G2_F8_FROM;
            pg8::DenseOrder S; S.init(NTOK, D, f8 ? D : 2 * D, P.G, (int)blockIdx.x, ws + WS_YAB, (const bf16*)(ws + WS_WBR) + (size_t)l * D * D);
            EpiBranch E{ws, l >= G3_F8_FROM};
            if (f8) pg8::gemm_phase<EpiBranch, pg8::DenseOrder, GM_G2, true, 1, true>(P.lds, P.tid, D, S, E);
            else pg8::gemm_phase<EpiBranch, pg8::DenseOrder, GM_G2, true>(P.lds, P.tid, D, S, E);
        GRID_BAR(); }
        for (int rep = 0; rep < (l == 0 ? REP_G3L0 : 1); ++rep) {
            Frame P; phase_frame(F, P); unsigned char* ws = P.ws;
            const bool f8 = l >= G3_F8_FROM;
            pg8::DenseOrder S; S.init(NTOK, D, f8 ? D : 2 * D, P.G, (int)blockIdx.x, ws + WS_XN, (const bf16*)(ws + WS_WOUT) + (size_t)l * D * D);
            EpiOut E{ws};
            if (f8) pg8::gemm_phase<EpiOut, pg8::DenseOrder, GM_G3, true, 1, true>(P.lds, P.tid, D, S, E);
            else pg8::gemm_phase<EpiOut, pg8::DenseOrder, GM_G3, true, KREP_G3>(P.lds, P.tid, D, S, E);
        GRID_BAR(); }
        for (int rep = 0; rep < REP_R2; ++rep) { { Frame P; phase_frame(F, P); r2_phase(P, l, rep < REP_R2 - 1); }
        GRID_BAR(); }
        { Frame P; phase_frame(F, P); moe_table(P, l); }
        for (int rep = 0; rep < REP_G4; ++rep) {
            Frame P; phase_frame(F, P); unsigned char* ws = P.ws;
            pg8::MoeOrder<true> S; S.rbs = (const LAS int*)(P.lds + MISC_OFF + 64); S.cnt = (const LAS int*)(P.lds + MISC_OFF + 256); S.ord = (const LAS int*)(P.lds + MISC_OFF + 512); S.npn = 4; S.vcu = P.vcu; S.G = P.G; S.pitch = D;
            S.A = (const char*)(ws + WS_XN); S.Bt = (const char*)(ws + WS_WGU + (size_t)l * NE * 1024 * D); S.bstride = (size_t)1024 * D; S.toklist = (const unsigned*)(ws + WS_TOKLIST);
            EpiGU E{ws};
            pg8::gemm_phase<EpiGU, pg8::MoeOrder<true>, GM_G4, true, 1, true, false>(P.lds, P.tid, D, S, E);
        GRID_BAR(); }
        for (int rep = 0; rep < REP_G5; ++rep) {
            Frame P; phase_frame(F, P); unsigned char* ws = P.ws;
            pg8::MoeOrder<false> S; S.rbs = (const LAS int*)(P.lds + MISC_OFF + 64); S.cnt = (const LAS int*)(P.lds + MISC_OFF + 256); S.ord = (const LAS int*)(P.lds + MISC_OFF + 512); S.npn = 8; S.vcu = P.vcu; S.G = P.G; S.pitch = DE;
            S.A = (const char*)(ws + WS_HMID); S.Bt = (const char*)(ws + WS_WD + (size_t)l * NE * D * DE); S.bstride = (size_t)D * DE; S.toklist = nullptr;
            EpiDown E{ws, l >= YS_F8_FROM};
            pg8::gemm_phase<EpiDown, pg8::MoeOrder<false>, GM_G5, true, KREP_G5, true, false>(P.lds, P.tid, DE, S, E);
        GRID_BAR(); }
        for (int rep = 0; rep < REP_R1; ++rep) {
        if (l == 0) { { Frame P; phase_frame(F, P); row_pass<1>(P, arg_in(P.kp, I_N1G) + D); } GRID_BAR(); }
        else { { Frame P; phase_frame(F, P); row_pass<2>(P, arg_in(P.kp, I_FG)); } if (rep < REP_R1 - 1) GRID_BAR(); } }
    }
}

extern "C" void kernel_launch(void* const* d_in, const int* in_sizes, int n_in, void* d_out, int out_size, void* d_ws, size_t ws_size, hipStream_t stream) {
    static int grid = 0;
    if (grid == 0) {
        if (n_in != 20 || in_sizes[0] != NTOK * D || out_size != NTOK * D || ws_size < WS_END) { fprintf(stderr, "kernel_launch: unexpected shapes / workspace (%d inputs, ws %zu)\n", n_in, ws_size); grid = -1; return; }
        int dev = 0, cus = 0;
        if (hipGetDevice(&dev) != hipSuccess || hipDeviceGetAttribute(&cus, hipDeviceAttributeMultiprocessorCount, dev) != hipSuccess) { grid = -1; return; }
        grid = cus;
    }
    if (grid < 0) return;
    (void)hipMemsetAsync((char*)d_ws + WS_CTL, 0, CTL_ZERO_BYTES, stream);
    Args a{};
    for (int i = 0; i < 20; ++i) a.in[i] = (const float*)d_in[i];
    a.out = (float*)d_out; a.ws = (unsigned char*)d_ws;
    hipLaunchKernelGGL(mk_fwd, dim3(grid), dim3(NWAVES * 64), 0, stream, a);
}
```
